# Optimizing an MI355X kernel written in HIP

```python
import math
import jax, jax.numpy as jnp
from jax import lax
import numpy as np

D_MODEL = 1024
BATCH = 8
SEQ = 2048
DEPTH = 1

MEM_LEN = 256
MEM_HEADS = 4
MEM_HEAD_DIM = D_MODEL // MEM_HEADS
A_HEADS = 8
A_HEAD_DIM = 64
A_WIDTH = A_HEADS * A_HEAD_DIM
MOBA_BLOCK = 256
MOBA_TOPK = 3
B_HEADS = 4
B_QK_DIM = 64
B_V_DIM = 2 * B_QK_DIM
B_QK_WIDTH = B_HEADS * 2 * B_QK_DIM
B_WIDTH = B_HEADS * B_V_DIM
MIX_WIDTH = A_WIDTH + B_WIDTH
IN_WIDTH = 3 * A_WIDTH + 2 * B_QK_WIDTH + B_WIDTH
IN_SPLITS = [A_WIDTH, 2 * A_WIDTH, 3 * A_WIDTH, 3 * A_WIDTH + B_QK_WIDTH, 3 * A_WIDTH + 2 * B_QK_WIDTH]
N_ATT_HEADS = A_HEADS + B_HEADS
REL_BUCKETS = 32
REL_MAX_DIST = 128
D_FF = -(-8 * D_MODEL // (3 * 256)) * 256
Q_BLOCK = 128
EPS = 1e-6
NEG_INF = -1e30

kernel_name = "hybrid_moba_diffattn_parallel_heads"


def rms_norm(x, g):
    xf = x.astype(jnp.float32)
    y = xf * lax.rsqrt(jnp.mean(xf * xf, axis=-1, keepdims=True) + EPS)
    return (y * g.astype(jnp.float32)).astype(x.dtype)


def rel_bucket(dist):
    n = jnp.maximum(dist, 0)
    max_exact = REL_BUCKETS // 2
    log_ratio = jnp.log(jnp.maximum(n, max_exact).astype(jnp.float32) / max_exact) / math.log(REL_MAX_DIST / max_exact)
    large = max_exact + (log_ratio * (REL_BUCKETS - max_exact)).astype(jnp.int32)
    large = jnp.minimum(large, REL_BUCKETS - 1)
    return jnp.where(n < max_exact, n, large)


def moba_attention(q, k, v, table_a):
    B_, S, H, dh = q.shape
    nb = -(-S // MOBA_BLOCK)
    pad = nb * MOBA_BLOCK - S
    topk = min(MOBA_TOPK, nb)
    n_chunks = S // Q_BLOCK
    scale = dh ** -0.5
    bias_ht = table_a.T.astype(jnp.float32)
    h_i = jnp.arange(H)[:, None, None]
    blk_ids = jnp.arange(nb)
    key_off = jnp.arange(MOBA_BLOCK)

    def per_batch(args):
        q1, k1, v1 = args
        kp = jnp.pad(k1, ((0, pad), (0, 0), (0, 0))).reshape(nb, MOBA_BLOCK, H, dh).transpose(2, 0, 1, 3)
        vp = jnp.pad(v1, ((0, pad), (0, 0), (0, 0))).reshape(nb, MOBA_BLOCK, H, dh).transpose(2, 0, 1, 3)
        kmean = jnp.mean(kp.astype(jnp.float32), axis=2)
        qc = q1.reshape(n_chunks, Q_BLOCK, H, dh).transpose(0, 2, 1, 3)

        def per_chunk(args2):
            qblk, c = args2
            t = c * Q_BLOCK + jnp.arange(Q_BLOCK)
            own = t // MOBA_BLOCK
            gate = jnp.einsum('hqd,hnd->hqn', qblk.astype(jnp.float32), kmean)
            gate = jnp.where(blk_ids[None, None, :] < own[None, :, None], gate, NEG_INF)
            _, sel = lax.top_k(gate, topk)
            idx = jnp.concatenate([sel, jnp.broadcast_to(own[None, :, None], (H, Q_BLOCK, 1))], axis=-1)
            k_sel = kp[h_i, idx]
            v_sel = vp[h_i, idx]
            logits = jnp.einsum('hqd,hqtld->hqtl', qblk, k_sel, preferred_element_type=jnp.float32) * scale
            kpos = idx[..., None] * MOBA_BLOCK + key_off
            dist = t[None, :, None, None] - kpos
            logits = logits + bias_ht[h_i[..., None], rel_bucket(dist)]
            slot_ok = jnp.concatenate([jnp.arange(topk)[None, :] < own[:, None],
                                       jnp.ones((Q_BLOCK, 1), dtype=bool)], axis=1)
            mask = slot_ok[None, :, :, None] & (dist >= 0)
            logits = jnp.where(mask, logits, NEG_INF)
            p = jax.nn.softmax(logits.reshape(H, Q_BLOCK, -1), axis=-1).reshape(logits.shape)
            out = jnp.einsum('hqtl,hqtld->hqd', p.astype(v_sel.dtype), v_sel, preferred_element_type=jnp.float32)
            return out.astype(q.dtype)

        outs = lax.map(per_chunk, (qc, jnp.arange(n_chunks)))
        return outs.transpose(0, 2, 1, 3).reshape(S, H, dh)

    return lax.map(per_batch, (q, k, v))


def diff_attention(q, k, v, table_b, lam, subln_g, lambda_init):
    B_, S, H, _, dq = q.shape
    n_chunks = S // Q_BLOCK
    scale = dq ** -0.5
    kt = k.transpose(0, 2, 3, 1, 4)
    vt = v.transpose(0, 2, 1, 3)
    qc = q.reshape(B_, n_chunks, Q_BLOCK, H, 2, dq).transpose(1, 0, 3, 4, 2, 5)
    bias_ht = table_b.T.astype(jnp.float32)
    s_pos = jnp.arange(S)

    def per_chunk(args):
        qblk, c = args
        t = c * Q_BLOCK + jnp.arange(Q_BLOCK)
        dist = t[:, None] - s_pos[None, :]
        bias = bias_ht[:, rel_bucket(dist)]
        logits = jnp.einsum('bhmqd,bhmsd->bhmqs', qblk, kt, preferred_element_type=jnp.float32) * scale
        logits = jnp.where(dist >= 0, logits + bias[None, :, None], NEG_INF)
        p = jax.nn.softmax(logits, axis=-1)
        attn = p[:, :, 0] - lam * p[:, :, 1]
        return jnp.einsum('bhqs,bhsd->bhqd', attn.astype(v.dtype), vt, preferred_element_type=jnp.float32)

    outs = lax.map(per_chunk, (qc, jnp.arange(n_chunks)))
    o = outs.transpose(1, 0, 3, 2, 4).reshape(B_, S, H, -1)
    o = rms_norm(o, subln_g) * (1.0 - lambda_init)
    return o.astype(v.dtype)


def memory_cross_attention(x, mem, norm_g, mem_g, wq, wk, wv, wo):
    B_, S, _ = x.shape
    M = mem.shape[1]
    h = rms_norm(x, norm_g)
    m = rms_norm(mem, mem_g)
    q = (h @ wq).reshape(B_, S, MEM_HEADS, MEM_HEAD_DIM)
    k = (m @ wk).reshape(B_, M, MEM_HEADS, MEM_HEAD_DIM)
    v = (m @ wv).reshape(B_, M, MEM_HEADS, MEM_HEAD_DIM)
    logits = jnp.einsum('bshd,bmhd->bhsm', q, k, preferred_element_type=jnp.float32) * (MEM_HEAD_DIM ** -0.5)
    p = jax.nn.softmax(logits, axis=-1)
    o = jnp.einsum('bhsm,bmhd->bshd', p.astype(v.dtype), v, preferred_element_type=jnp.float32).astype(x.dtype)
    return o.reshape(B_, S, MEM_HEADS * MEM_HEAD_DIM) @ wo


def swiglu(x, norm_g, w_gate, w_up, w_down):
    h = rms_norm(x, norm_g)
    return (jax.nn.silu(h @ w_gate) * (h @ w_up)) @ w_down


def setup_inputs(seed: int = 0) -> dict:
    key = jax.random.key(seed)
    ks = jax.random.split(key, 24)
    f32 = jnp.float32

    def w(k, shape, fan_in):
        return jax.random.normal(k, shape, f32) * (fan_in ** -0.5)

    def gain(k, shape):
        return 1.0 + 0.02 * jax.random.normal(k, shape, f32)

    return {
        "x": jax.random.normal(ks[0], (BATCH, SEQ, D_MODEL), f32),
        "mem": jax.random.normal(ks[1], (BATCH, MEM_LEN, D_MODEL), f32),
        "mix_norm_g": gain(ks[2], (DEPTH, D_MODEL)),
        "w_in": w(ks[3], (DEPTH, D_MODEL, IN_WIDTH), D_MODEL),
        "moba_out_g": gain(ks[4], (DEPTH, A_WIDTH)),
        "diff_lambda": 0.1 * jax.random.normal(ks[5], (DEPTH, 4, B_QK_DIM), f32),
        "diff_subln_g": gain(ks[6], (DEPTH, B_V_DIM)),
        "w_out": w(ks[7], (DEPTH, MIX_WIDTH, D_MODEL), MIX_WIDTH),
        "rel_bias_table": 0.5 * jax.random.normal(ks[8], (REL_BUCKETS, N_ATT_HEADS), f32),
        "cross_norm_g": gain(ks[9], (DEPTH, D_MODEL)),
        "mem_norm_g": gain(ks[10], (DEPTH, D_MODEL)),
        "w_cq": w(ks[11], (DEPTH, D_MODEL, MEM_HEADS * MEM_HEAD_DIM), D_MODEL),
        "w_ck": w(ks[12], (DEPTH, D_MODEL, MEM_HEADS * MEM_HEAD_DIM), D_MODEL),
        "w_cv": w(ks[13], (DEPTH, D_MODEL, MEM_HEADS * MEM_HEAD_DIM), D_MODEL),
        "w_co": w(ks[14], (DEPTH, MEM_HEADS * MEM_HEAD_DIM, D_MODEL), MEM_HEADS * MEM_HEAD_DIM),
        "ffn_norm_g": gain(ks[15], (DEPTH, D_MODEL)),
        "w_gate": w(ks[16], (DEPTH, D_MODEL, D_FF), D_MODEL),
        "w_up": w(ks[17], (DEPTH, D_MODEL, D_FF), D_MODEL),
        "w_down": w(ks[18], (DEPTH, D_FF, D_MODEL), D_FF),
        "final_norm_g": gain(ks[19], (D_MODEL,)),
    }


def reference(x, mem, mix_norm_g, w_in, moba_out_g, diff_lambda, diff_subln_g, w_out, rel_bias_table,
              cross_norm_g, mem_norm_g, w_cq, w_ck, w_cv, w_co, ffn_norm_g, w_gate, w_up, w_down,
              final_norm_g):
    B_, S, _ = x.shape
    table_a = rel_bias_table[:, :A_HEADS]
    table_b = rel_bias_table[:, A_HEADS:]
    for l in range(DEPTH):
        h = rms_norm(x, mix_norm_g[l])
        proj = jnp.einsum('bsd,de->bse', h, w_in[l])
        qa, ka, va, qb, kb, vb = jnp.split(proj, IN_SPLITS, axis=-1)
        oa = moba_attention(qa.reshape(B_, S, A_HEADS, A_HEAD_DIM),
                            ka.reshape(B_, S, A_HEADS, A_HEAD_DIM),
                            va.reshape(B_, S, A_HEADS, A_HEAD_DIM), table_a)
        oa = rms_norm(oa.reshape(B_, S, A_WIDTH), moba_out_g[l])
        lambda_init = 0.8 - 0.6 * math.exp(-0.3 * l)
        lp = diff_lambda[l].astype(jnp.float32)
        lam = jnp.exp(jnp.sum(lp[0] * lp[1])) - jnp.exp(jnp.sum(lp[2] * lp[3])) + lambda_init
        ob = diff_attention(qb.reshape(B_, S, B_HEADS, 2, B_QK_DIM),
                            kb.reshape(B_, S, B_HEADS, 2, B_QK_DIM),
                            vb.reshape(B_, S, B_HEADS, B_V_DIM),
                            table_b, lam, diff_subln_g[l], lambda_init)
        ob = ob.reshape(B_, S, B_WIDTH)
        mixed = jnp.concatenate([oa, ob], axis=-1)
        x = x + jnp.einsum('bse,ed->bsd', mixed, w_out[l])
        x = x + memory_cross_attention(x, mem, cross_norm_g[l], mem_norm_g[l], w_cq[l], w_ck[l], w_cv[l], w_co[l])
        x = x + swiglu(x, ffn_norm_g[l], w_gate[l], w_up[l], w_down[l])
    return rms_norm(x, final_norm_g)
```

```cpp
#include <hip/hip_runtime.h>
#include <hip/hip_bf16.h>
#include <cstdio>
#include <cstdint>
namespace pg8 {
#define PG8_LAS __attribute__((address_space(3)))
typedef unsigned short bf16_t;
typedef short bf16x8 __attribute__((ext_vector_type(8)));
typedef float f32x4 __attribute__((ext_vector_type(4)));
typedef unsigned u32x4 __attribute__((ext_vector_type(4)));
constexpr int BM = 256, BK = 64, HALF = 128, HTB = HALF * BK * 2  , STAGE_BYTES = 8 * HTB, NXCD = 8, WGM = 8;

__host__ __device__ __forceinline__ int lds_byte(int r, int c) { const int st = (r >> 4) * 2 + (c >> 5), rr = r & 15, cc = c & 31, ob = rr * 64 + cc * 2; return st * 1024 + (ob ^ (((ob >> 9) & 1) << 5)); }
__host__ __device__ __forceinline__ void stage_rc(int b, int& R, int& C) { const int st = b / 1024, sb = b % 1024, swz = sb ^ (((sb >> 9) & 1) << 5); R = (st >> 1) * 16 + swz / 64; C = (st & 1) * 32 + (swz % 64) / 2; }
__host__ __device__ __forceinline__ int perm32(int rho) { const int n = rho >> 4, i = rho & 15; return 8 * (i >> 2) + 4 * n + (i & 3); }

struct Unit { int pm, pn; };
struct Gemm { const bf16_t* A; const bf16_t* Bt; int M, N, K; };

struct StaticOrder {
    int nM, nN, nwg, G, c;
    __host__ __device__ void init(int M, int N, int G_, int c_) { nM = M / BM; nN = N / BM; nwg = nM * nN; G = G_; c = c_; }
    __host__ __device__ bool next(int i, Unit& u) const {
        const long L = (long)i * G + c; if (L >= nwg) return false;
        int wgid = (int)L; { const int q = nwg / NXCD, r = nwg % NXCD, xcd = wgid % NXCD, off = wgid / NXCD; wgid = (xcd < r ? xcd * (q + 1) : r * (q + 1) + (xcd - r) * q) + off; }
        const int nig = WGM * nN, gid = wgid / nig, fm = gid * WGM, gsz = (nM - fm) < WGM ? (nM - fm) : WGM;
        u.pm = fm + ((wgid % nig) % gsz); u.pn = (wgid % nig) / gsz; return true;
    }
    __device__ __forceinline__ void a_ready(const Unit&) const {}
    __device__ __forceinline__ void done(const Unit&) const {}
};

__device__ __forceinline__ unsigned cvt_pk_bf16(float lo, float hi) { unsigned r; asm volatile("v_cvt_pk_bf16_f32 %0, %1, %2" : "=v"(r) : "v"(lo), "v"(hi)); return r; }
typedef float f32x2 __attribute__((ext_vector_type(2)));
typedef unsigned u32x2v __attribute__((ext_vector_type(2)));
__device__ __forceinline__ float bf_lo(unsigned w) { return __uint_as_float(w << 16); }
__device__ __forceinline__ float bf_hi(unsigned w) { return __uint_as_float(w & 0xffff0000u); }
__device__ __forceinline__ float row_rstd(const float* ssq, int row) { const f32x4 s = *(const f32x4*)(ssq + (size_t)row * 4); return 1.0f / sqrtf(((s[0] + s[1]) + (s[2] + s[3])) * (1.0f / 1024.0f) + 1e-6f); }

struct EpiStore {
    static constexpr bool PERM = true, AFTER_DRAIN = false;
    bf16_t* O; int ldc; const float* ssq;
    __device__ __forceinline__ void operator()(const f32x4 (&acc)[2][2][4][2], const Unit& u, int wr, int wc, int fr, int fq) const {
        const int row0 = u.pm * BM + wr * 64 + fr, col0 = u.pn * BM + wc * 32 + 8 * fq;
#pragma unroll
        for (int ai = 0; ai < 2; ++ai)
#pragma unroll
            for (int m = 0; m < 4; ++m) { const int row = row0 + ai * HALF + m * 16; const float sc = ssq ? row_rstd(ssq, row) : 1.0f; bf16_t* rowp = O + (size_t)row * ldc + col0;
#pragma unroll
                for (int bj = 0; bj < 2; ++bj) { const f32x4 v0 = acc[ai][bj][m][0] * sc, v1 = acc[ai][bj][m][1] * sc;
                    u32x4 w; w.x = cvt_pk_bf16(v0[0], v0[1]); w.y = cvt_pk_bf16(v0[2], v0[3]); w.z = cvt_pk_bf16(v1[0], v1[1]); w.w = cvt_pk_bf16(v1[2], v1[3]);
                    *(u32x4*)(rowp + bj * HALF) = w; } }
    }
};
struct EpiSwiGLU {
    static constexpr bool PERM = true, AFTER_DRAIN = false;
    bf16_t* H; int ldh; const float* ssq;
    __device__ __forceinline__ void operator()(const f32x4 (&acc)[2][2][4][2], const Unit& u, int wr, int wc, int fr, int fq) const {
        const int row0 = u.pm * BM + wr * 64 + fr, col0 = u.pn * HALF + wc * 32 + 8 * fq;
#pragma unroll
        for (int ai = 0; ai < 2; ++ai)
#pragma unroll
            for (int m = 0; m < 4; ++m) { const int row = row0 + ai * HALF + m * 16; const float sc = row_rstd(ssq, row);
                float h[8];
#pragma unroll
                for (int n = 0; n < 2; ++n)
#pragma unroll
                    for (int i = 0; i < 4; ++i) { const float g = acc[ai][0][m][n][i] * sc, up = acc[ai][1][m][n][i] * sc;
                        const float e = __builtin_amdgcn_exp2f(g * -1.4426950408889634f);
                        h[n * 4 + i] = g * up * __builtin_amdgcn_rcpf(1.0f + e); }
                u32x4 w; w.x = cvt_pk_bf16(h[0], h[1]); w.y = cvt_pk_bf16(h[2], h[3]); w.z = cvt_pk_bf16(h[4], h[5]); w.w = cvt_pk_bf16(h[6], h[7]);
                *(u32x4*)(H + (size_t)row * ldh + col0) = w; }
    }
};
template <bool RES_F32, bool OUT_F32> struct EpiResid {
    static constexpr bool PERM = true, AFTER_DRAIN = true;
    const void* resid; void* out; float* ssq; int ld;
    __device__ __forceinline__ void fused(f32x4 (&acc)[2][2][4][2], const Unit& u, int wr, int wc, int fr, int fq, PG8_LAS unsigned char* lds, int wid, int lane) const {
        PG8_LAS float* P = (PG8_LAS float*)lds;
        const int col0 = u.pn * BM + wc * 32 + 8 * fq;
#pragma unroll
        for (int ai = 0; ai < 2; ++ai)
#pragma unroll
            for (int m = 0; m < 4; ++m) { const int rl = ai * HALF + wr * 64 + m * 16 + fr; const size_t off = (size_t)(u.pm * BM + rl) * ld + col0; float s = 0.f;
#pragma unroll
                for (int bj = 0; bj < 2; ++bj) { f32x4 v0 = acc[ai][bj][m][0], v1 = acc[ai][bj][m][1];
                    if (RES_F32) { const float* rp = (const float*)resid + off + bj * HALF; v0 += *(const f32x4*)rp; v1 += *(const f32x4*)(rp + 4); }
                    else { const u32x4 rw = *(const u32x4*)((const bf16_t*)resid + off + bj * HALF);
                        v0 += (f32x4){bf_lo(rw.x), bf_hi(rw.x), bf_lo(rw.y), bf_hi(rw.y)}; v1 += (f32x4){bf_lo(rw.z), bf_hi(rw.z), bf_lo(rw.w), bf_hi(rw.w)}; }
                    s += (v0[0] * v0[0] + v0[1] * v0[1]) + (v0[2] * v0[2] + v0[3] * v0[3]) + (v1[0] * v1[0] + v1[1] * v1[1]) + (v1[2] * v1[2] + v1[3] * v1[3]);
                    if (OUT_F32) { float* op = (float*)out + off + bj * HALF; *(f32x4*)op = v0; *(f32x4*)(op + 4) = v1; }
                    else { u32x4 w; w.x = cvt_pk_bf16(v0[0], v0[1]); w.y = cvt_pk_bf16(v0[2], v0[3]); w.z = cvt_pk_bf16(v1[0], v1[1]); w.w = cvt_pk_bf16(v1[2], v1[3]);
                        *(u32x4*)((bf16_t*)out + off + bj * HALF) = w; } }
                s += __shfl_xor(s, 16); s += __shfl_xor(s, 32);
                if (ssq != nullptr && fq == 0) P[rl * 4 + wc] = s; }
        if (ssq != nullptr) {
            asm volatile("s_waitcnt lgkmcnt(0)" ::: "memory"); __builtin_amdgcn_s_barrier(); asm volatile("" ::: "memory");
            const int t = wid * 64 + lane;
            if (t < 256) { const float a = P[t * 4 + 0], b = P[t * 4 + 1], c = P[t * 4 + 2], d = P[t * 4 + 3]; ssq[(size_t)(u.pm * BM + t) * 4 + u.pn] = (a + b) + (c + d); }
        }
    }
};

template <class Epi, class Sched, bool ALIGN_EPI = false, bool SP2 = false>
__device__ __forceinline__ void gemm_phase(PG8_LAS unsigned char* lds, const Gemm g, const Sched& S, const Epi& E) {
    const int tid = threadIdx.x, wid = __builtin_amdgcn_readfirstlane(tid >> 6), lane = tid & 63, wr = wid >> 2, wc = wid & 3, fr = lane & 15, fq = lane >> 4;
    const int K = g.K, nt = K / BK;
    unsigned voffA[2], voffB[2];
#pragma unroll
    for (int i = 0; i < 2; ++i) { int R, C; stage_rc(tid * 16 + i * 8192, R, C); const int Rb = Epi::PERM ? ((R & ~31) + perm32(R & 31)) : R;
        voffA[i] = (unsigned)(R * K + C) * 2u; voffB[i] = (unsigned)(Rb * K + C) * 2u; }
    const size_t kstep = (size_t)(BK * 2);
    const size_t hstep = (size_t)HALF * K * 2;
    const size_t tstep = 2 * hstep;
    const unsigned ldsw = (unsigned)wid * 1024u;
    const int aoff = lds_byte(wr * 64 + fr, fq * 8), boff = lds_byte(wc * 32 + fr, fq * 8);
#define PG8_SA(b, h) (((b) * 2 + (h)) * HTB)
#define PG8_SB(b, h) ((4 + (b) * 2 + (h)) * HTB)
#define PG8_STAGE(bufoff, gbase, voff) do { _Pragma("unroll") for (int _i = 0; _i < 2; ++_i) \
        __builtin_amdgcn_global_load_lds((const unsigned*)((const char*)(gbase) + (voff)[_i]), (PG8_LAS unsigned*)(lds + (bufoff) + ldsw + _i * 8192), 16, 0, 0); } while (0)
#define PG8_LDA(dst, b, h) do { _Pragma("unroll") for (int m = 0; m < 4; ++m) _Pragma("unroll") for (int k = 0; k < 2; ++k) dst[m][k] = *(const PG8_LAS bf16x8*)(lds + PG8_SA(b, h) + aoff + m * 2048 + k * 1024); } while (0)
#define PG8_LDB(dst, b, h) do { _Pragma("unroll") for (int n = 0; n < 2; ++n) _Pragma("unroll") for (int k = 0; k < 2; ++k) dst[n][k] = *(const PG8_LAS bf16x8*)(lds + PG8_SB(b, h) + boff + n * 2048 + k * 1024); } while (0)
#define PG8_MMA(ai, bj, At, Bt) do { __builtin_amdgcn_s_setprio(1); _Pragma("unroll") for (int m = 0; m < 4; ++m) _Pragma("unroll") for (int n = 0; n < 2; ++n) _Pragma("unroll") for (int k = 0; k < 2; ++k) \
        acc[ai][bj][m][n] = __builtin_amdgcn_mfma_f32_16x16x32_bf16(Bt[n][k], At[m][k], acc[ai][bj][m][n], 0, 0, 0); __builtin_amdgcn_s_setprio(0); } while (0)
#define PG8_WAIT_V(n) asm volatile("s_waitcnt vmcnt(" #n ")" ::: "memory")
#define PG8_WAIT_L(n) asm volatile("s_waitcnt lgkmcnt(" #n ")" ::: "memory")
#define PG8_BAR __builtin_amdgcn_s_barrier()
#define PG8_SCHED __builtin_amdgcn_sched_barrier(0)
    Unit cur, nxt; int ui = 0;
    if (!S.next(0, cur)) return;
    f32x4 acc[2][2][4][2];
#pragma unroll
    for (int a = 0; a < 2; ++a)
#pragma unroll
        for (int b = 0; b < 2; ++b)
#pragma unroll
            for (int m = 0; m < 4; ++m)
#pragma unroll
                for (int n = 0; n < 2; ++n) acc[a][b][m][n] = (f32x4){0.f, 0.f, 0.f, 0.f};
    bf16x8 At[4][2], B0[2][2], B1[2][2];
    const char* cA = (const char*)g.A + (size_t)cur.pm * tstep; const char* cB = (const char*)g.Bt + (size_t)cur.pn * tstep;
    S.a_ready(cur);
    if constexpr (SP2) {
        PG8_STAGE(PG8_SB(0, 0), cB, voffB); PG8_STAGE(PG8_SB(0, 1), cB + hstep, voffB); PG8_STAGE(PG8_SA(0, 0), cA, voffA); PG8_STAGE(PG8_SA(0, 1), cA + hstep, voffA);
        if (wr == 1) PG8_BAR;
        PG8_WAIT_V(2); PG8_BAR;
        PG8_STAGE(PG8_SB(1, 0), cB + kstep, voffB); PG8_STAGE(PG8_SA(1, 0), cA + kstep, voffA); PG8_STAGE(PG8_SB(1, 1), cB + hstep + kstep, voffB);
        PG8_WAIT_V(6); PG8_BAR;
    } else {
        PG8_STAGE(PG8_SB(0, 0), cB, voffB); PG8_STAGE(PG8_SA(0, 0), cA, voffA); PG8_STAGE(PG8_SB(0, 1), cB + hstep, voffB); PG8_STAGE(PG8_SA(0, 1), cA + hstep, voffA);
        if (wr == 1) PG8_BAR;
        PG8_WAIT_V(4); PG8_BAR;
        PG8_STAGE(PG8_SB(1, 0), cB + kstep, voffB); PG8_STAGE(PG8_SA(1, 0), cA + kstep, voffA); PG8_STAGE(PG8_SB(1, 1), cB + hstep + kstep, voffB);
        PG8_WAIT_V(6); PG8_BAR;
    }
    for (;;) {
        const bool has_next = S.next(ui + 1, nxt);
        const char* nA = has_next ? (const char*)g.A + (size_t)nxt.pm * tstep : cA; const char* nB = has_next ? (const char*)g.Bt + (size_t)nxt.pn * tstep : cB;
        for (int t = 0; t < nt; t += 2) {
            const bool last = (t == nt - 2);
            const char* a1 = cA + (size_t)(t + 1) * kstep;
            const char* a2 = last ? nA : cA + (size_t)(t + 2) * kstep; const char* b2 = last ? nB : cB + (size_t)(t + 2) * kstep;
            const char* a3 = a2 + kstep; const char* b3 = b2 + kstep;
            if (last && has_next) S.a_ready(nxt);
            if constexpr (SP2) {
            PG8_LDB(B0, 0, 0); PG8_LDB(B1, 0, 1); PG8_SCHED; PG8_LDA(At, 0, 0); PG8_STAGE(PG8_SA(1, 1), a1 + hstep, voffA);
            PG8_WAIT_V(8); PG8_WAIT_L(0); PG8_BAR; PG8_MMA(0, 0, At, B0); PG8_MMA(0, 1, At, B1); PG8_BAR; PG8_SCHED;
            PG8_LDA(At, 0, 1); PG8_STAGE(PG8_SB(0, 0), b2, voffB); PG8_STAGE(PG8_SB(0, 1), b2 + hstep, voffB); PG8_STAGE(PG8_SA(0, 0), a2, voffA);
            PG8_WAIT_V(8); PG8_WAIT_L(0); PG8_BAR; PG8_MMA(1, 0, At, B0); PG8_MMA(1, 1, At, B1); PG8_BAR; PG8_SCHED;
            PG8_LDB(B0, 1, 0); PG8_LDB(B1, 1, 1); PG8_SCHED; PG8_LDA(At, 1, 0); PG8_STAGE(PG8_SA(0, 1), a2 + hstep, voffA);
            PG8_WAIT_V(8); PG8_WAIT_L(0); PG8_BAR; PG8_MMA(0, 0, At, B0); PG8_MMA(0, 1, At, B1); PG8_BAR; PG8_SCHED;
            PG8_LDA(At, 1, 1); PG8_STAGE(PG8_SB(1, 0), b3, voffB); PG8_STAGE(PG8_SB(1, 1), b3 + hstep, voffB); PG8_STAGE(PG8_SA(1, 0), a3, voffA);
            PG8_WAIT_V(8); PG8_WAIT_L(0); PG8_BAR; PG8_MMA(1, 0, At, B0); PG8_MMA(1, 1, At, B1); PG8_BAR; PG8_SCHED;
            } else {
            PG8_LDB(B0, 0, 0); PG8_SCHED; PG8_LDA(At, 0, 0); PG8_STAGE(PG8_SA(1, 1), a1 + hstep, voffA);
            PG8_WAIT_L(8); PG8_BAR; PG8_WAIT_L(0); PG8_MMA(0, 0, At, B0); PG8_BAR; PG8_SCHED;
            PG8_LDB(B1, 0, 1); PG8_STAGE(PG8_SB(0, 0), b2, voffB);
            PG8_BAR; PG8_WAIT_L(0); PG8_MMA(0, 1, At, B1); PG8_BAR;
            PG8_LDA(At, 0, 1); PG8_STAGE(PG8_SA(0, 0), a2, voffA);
            PG8_BAR; PG8_WAIT_L(0); PG8_MMA(1, 0, At, B0); PG8_BAR; PG8_SCHED;
            PG8_STAGE(PG8_SB(0, 1), b2 + hstep, voffB);
            PG8_WAIT_V(6); PG8_BAR; PG8_MMA(1, 1, At, B1); PG8_BAR;
            PG8_LDB(B0, 1, 0); PG8_SCHED; PG8_LDA(At, 1, 0); PG8_STAGE(PG8_SA(0, 1), a2 + hstep, voffA);
            PG8_WAIT_L(8); PG8_BAR; PG8_WAIT_L(0); PG8_MMA(0, 0, At, B0); PG8_BAR; PG8_SCHED;
            PG8_LDB(B1, 1, 1); PG8_STAGE(PG8_SB(1, 0), b3, voffB);
            PG8_BAR; PG8_WAIT_L(0); PG8_MMA(0, 1, At, B1); PG8_BAR;
            PG8_LDA(At, 1, 1); PG8_STAGE(PG8_SA(1, 0), a3, voffA);
            PG8_BAR; PG8_WAIT_L(0); PG8_MMA(1, 0, At, B0); PG8_BAR; PG8_SCHED;
            PG8_STAGE(PG8_SB(1, 1), b3 + hstep, voffB);
            PG8_WAIT_V(6); PG8_BAR; PG8_MMA(1, 1, At, B1); PG8_BAR;
            }
        }
        if constexpr (ALIGN_EPI) { if (wr == 0) PG8_BAR; }
        if constexpr (!Epi::AFTER_DRAIN) { E(acc, cur, wr, wc, fr, fq); S.done(cur); }
        if (!has_next) break;
#pragma unroll
        for (int a = 0; a < 2; ++a)
#pragma unroll
            for (int b = 0; b < 2; ++b)
#pragma unroll
                for (int m = 0; m < 4; ++m)
#pragma unroll
                    for (int n = 0; n < 2; ++n) acc[a][b][m][n] = (f32x4){0.f, 0.f, 0.f, 0.f};
        cur = nxt; cA = nA; cB = nB; ++ui;
        if constexpr (ALIGN_EPI) { if (wr == 1) PG8_BAR; }
    }
    PG8_WAIT_V(0);
    if constexpr (!ALIGN_EPI) { if (wr == 0) PG8_BAR; }
    PG8_BAR;
    if constexpr (Epi::AFTER_DRAIN) { E.fused(acc, cur, wr, wc, fr, fq, lds, wid, lane); S.done(cur); }
#undef PG8_SA
#undef PG8_SB
#undef PG8_STAGE
#undef PG8_LDA
#undef PG8_LDB
#undef PG8_MMA
#undef PG8_WAIT_V
#undef PG8_WAIT_L
#undef PG8_BAR
#undef PG8_SCHED
}
}
namespace att {
#define ALAS __attribute__((address_space(3)))
using bf16x8 = __attribute__((ext_vector_type(8))) short;
using s16x4 = __attribute__((ext_vector_type(4))) short;
using f32x16 = __attribute__((ext_vector_type(16))) float;
using u32x4 = __attribute__((ext_vector_type(4))) unsigned;
typedef short v4i16_t __attribute__((ext_vector_type(4)));
typedef float f32x2_t __attribute__((ext_vector_type(2))); typedef __bf16 bf16x2_t __attribute__((ext_vector_type(2)));
typedef unsigned short bf16;
typedef ALAS const char* lds_cptr;
constexpr float NEGV = -30000.f;
constexpr float MINIT = -100.f;
constexpr float THR = 8.f;
__device__ __forceinline__ int crow(int r, int hi) { return (r & 3) + 8 * (r >> 2) + 4 * hi; }
__device__ __forceinline__ void glds16(const void* gsrc, unsigned lds_dst) { unsigned keep;
    asm volatile("s_mov_b32 %0, m0\n\ts_mov_b32 m0, %2\n\ts_nop 0\n\tglobal_load_lds_dwordx4 %1, off\n\ts_mov_b32 m0, %0" : "=&s"(keep) : "v"(gsrc), "s"(lds_dst) : "memory"); }
__device__ __forceinline__ unsigned cvtpk(float lo, float hi) { f32x2_t v = {lo, hi}; bf16x2_t b = __builtin_convertvector(v, bf16x2_t); return __builtin_bit_cast(unsigned, b); }
__device__ __forceinline__ float bf2f(short s) { return __uint_as_float(((unsigned)(unsigned short)s) << 16); }
__device__ __forceinline__ s16x4 vtr(lds_cptr p) { return __builtin_bit_cast(s16x4, __builtin_amdgcn_ds_read_tr16_b64_v4i16((ALAS v4i16_t*)p)); }
__device__ __forceinline__ float swap_add(float v) { auto rr = __builtin_amdgcn_permlane32_swap(__float_as_uint(v), __float_as_uint(v), false, false); return __uint_as_float(rr[0]) + __uint_as_float(rr[1]); }
__device__ __forceinline__ float swap_max(float v) { auto rr = __builtin_amdgcn_permlane32_swap(__float_as_uint(v), __float_as_uint(v), false, false); return __builtin_fmaxf(__uint_as_float(rr[0]), __uint_as_float(rr[1])); }
#define ATT_WAIT_BAR(N) asm volatile("s_waitcnt vmcnt(" #N ") lgkmcnt(0)\n\ts_barrier" ::: "memory")
#define ATT_MFMA(a, b, c) __builtin_amdgcn_mfma_f32_32x32x16_bf16((a), (b), (c), 0, 0, 0)

constexpr int SPITCH = 3072;
constexpr int SEQ = 2048;
template <int DV> struct SelfLay { static constexpr int VS = 64 * DV * 2, K0 = 0, V0 = 3 * 8192, WS = V0 + 3 * VS, END = WS + 8 * 256; };

template <int DV, bool MOBA>
__device__ __forceinline__ void self_unit(ALAS unsigned char* lds, const bf16* Qp, const bf16* Kp, const bf16* Vp, bf16* Op, int opitch, int qb, const ALAS float* tab) {
    typedef SelfLay<DV> L;
    constexpr int NDV = DV / 32, NVP = DV / 64;
    const int tid = threadIdx.x, lane = tid & 63, r32 = lane & 31, hi = lane >> 5; const int wid = __builtin_amdgcn_readfirstlane(tid >> 6);
    const int q0 = qb * 256, qw = q0 + wid * 32, qpos = qw + r32;
    const int NT = (q0 + 256) / 64;
    const unsigned lds0 = (unsigned)(uintptr_t)lds;
    ALAS float* wsf = (ALAS float*)(lds + L::WS) + wid * 64;
    ALAS float* wsfh = wsf + 4 * hi;
    bf16x8 qr[4];
#pragma unroll
    for (int s = 0; s < 4; ++s) qr[s] = *(const bf16x8*)(Qp + (size_t)(qw + r32) * SPITCH + s * 16 + hi * 8);
    unsigned selmask = 0xffu;
    if constexpr (MOBA) {
        if (qb >= 4) {
            ALAS float* part = (ALAS float*)lds;
            ALAS float* km = (ALAS float*)(lds + 16384);
            const int c = tid & 7, rg = tid >> 3;
            for (int n = 0; n < qb; ++n) {
                float a[8];
#pragma unroll
                for (int j = 0; j < 8; ++j) a[j] = 0.f;
#pragma unroll
                for (int i = 0; i < 4; ++i) { const bf16x8 v = *(const bf16x8*)(Kp + (size_t)(n * 256 + rg + 64 * i) * SPITCH + c * 8);
#pragma unroll
                    for (int j = 0; j < 8; ++j) a[j] += bf2f(v[j]); }
#pragma unroll
                for (int j = 0; j < 8; ++j) { a[j] += __shfl_xor(a[j], 8); a[j] += __shfl_xor(a[j], 16); a[j] += __shfl_xor(a[j], 32); }
                if ((lane >> 3) == 0) {
#pragma unroll
                    for (int j = 0; j < 8; ++j) part[(wid * 7 + n) * 64 + c * 8 + j] = a[j]; }
            }
            asm volatile("s_waitcnt lgkmcnt(0)\n\ts_barrier" ::: "memory");
            if (tid < 448 && (tid >> 6) < qb) { float s = 0.f;
#pragma unroll
                for (int w = 0; w < 8; ++w) s += part[(w * 7 + (tid >> 6)) * 64 + (tid & 63)];
                km[tid] = s; }
            asm volatile("s_waitcnt lgkmcnt(0)\n\ts_barrier" ::: "memory");
            float g[7];
#pragma unroll
            for (int n = 0; n < 7; ++n) { float s = 0.f;
                if (n < qb) {
#pragma unroll
                    for (int s4 = 0; s4 < 4; ++s4)
#pragma unroll
                        for (int j = 0; j < 8; ++j) s += bf2f(qr[s4][j]) * km[n * 64 + 16 * s4 + 8 * hi + j];
                }
                s = swap_add(s); g[n] = (n < qb) ? s : -3.0e38f; }
            selmask = 0u;
#pragma unroll
            for (int i = 0; i < 7; ++i) { int cnt = 0;
#pragma unroll
                for (int j = 0; j < 7; ++j) if (j != i) cnt += (g[j] > g[i] || (g[j] == g[i] && j < i)) ? 1 : 0;
                if (i < qb && cnt < 3) selmask |= 1u << i; }
            asm volatile("s_waitcnt lgkmcnt(0)\n\ts_barrier" ::: "memory");
        }
    }
    const bf16* ksrc = Kp + (size_t)lane * SPITCH + wid * 8;
    const unsigned kdst = lds0 + L::K0 + wid * 1024;
#define ATT_DMA_K(t, slot) glds16(ksrc + (size_t)(t) * 64 * SPITCH, (unsigned)__builtin_amdgcn_readfirstlane(kdst + (slot) * 8192))
#define ATT_DMA_V(t, slot) do { _Pragma("unroll") for (int i_ = 0; i_ < NVP; ++i_) { const int p_ = wid + 8 * i_; \
        glds16(Vp + (size_t)((t) * 64 + 16 * (p_ & 3) + (lane >> 2)) * SPITCH + (p_ >> 2) * 32 + (lane & 3) * 8, (unsigned)__builtin_amdgcn_readfirstlane(lds0 + L::V0 + (slot) * L::VS + p_ * 1024)); } } while (0)
    ATT_DMA_K(0, 0); ATT_DMA_V(0, 0); ATT_DMA_K(1, 1); ATT_DMA_V(1, 1);
    float mhat = MINIT, lsum = 0.f; f32x16 o[NDV];
#pragma unroll
    for (int d = 0; d < NDV; ++d) o[d] = f32x16{};
    f32x16 negm;
#pragma unroll
    for (int r = 0; r < 16; ++r) negm[r] = -MINIT;
    const lds_cptr kp0 = (lds_cptr)lds + L::K0 + hi * 1024 + r32 * 16;
    const lds_cptr vp0 = (lds_cptr)lds + L::V0 + ((lane >> 4) & 1) * 32 + (lane & 3) * 8 + (4 * hi + ((lane & 15) >> 2)) * 64;
    int slot = 0, slot2 = 2;
    for (int t = 0; t < NT; ++t) {
        if (t + 1 < NT) { if (NVP == 1) ATT_WAIT_BAR(2); else ATT_WAIT_BAR(3); } else ATT_WAIT_BAR(0);
        if (t + 2 < NT) { ATT_DMA_K(t + 2, slot2); ATT_DMA_V(t + 2, slot2); }
        if (64 * t <= qw + 31) {
            f32x16 ci = negm;
            if constexpr (MOBA) { const int blk = t >> 2; if (blk < qb) { const bool keep = (selmask >> blk) & 1u;
#pragma unroll
                for (int r = 0; r < 16; ++r) ci[r] = keep ? negm[r] : NEGV; } }
            f32x16 p0, p1;
            { const lds_cptr kp = kp0 + slot * 8192;
#pragma unroll
              for (int s = 0; s < 4; ++s) { const bf16x8 k0 = *(const ALAS bf16x8*)(kp + s * 2048), k1 = *(const ALAS bf16x8*)(kp + s * 2048 + 512);
                  if (s == 0) { p0 = ATT_MFMA(k0, qr[0], ci); p1 = ATT_MFMA(k1, qr[0], ci); } else { p0 = ATT_MFMA(k0, qr[s], p0); p1 = ATT_MFMA(k1, qr[s], p1); } } }
            if (64 * t + 191 > qw) {
                const int kb = 64 * t + 4 * hi;
#pragma unroll
                for (int r = 0; r < 16; ++r) { const int d0 = qpos - (kb + (r & 3) + 8 * (r >> 2)), d1 = d0 - 32;
                    const float b0 = tab[d0 < 0 ? 0 : (d0 > 128 ? 128 : d0)], b1 = tab[d1 < 0 ? 0 : (d1 > 128 ? 128 : d1)];
                    p0[r] = d0 < 0 ? NEGV : p0[r] + b0; p1[r] = d1 < 0 ? NEGV : p1[r] + b1; }
            }
            float rm = __builtin_fmaxf(p0[0], p1[0]);
#pragma unroll
            for (int r = 1; r < 16; ++r) rm = __builtin_fmaxf(rm, __builtin_fmaxf(p0[r], p1[r]));
            rm = swap_max(rm);
            if (__any(rm > THR)) {
                const float dl = __builtin_fmaxf(rm, 0.f); mhat += dl;
#pragma unroll
                for (int r = 0; r < 16; ++r) { p0[r] -= dl; p1[r] -= dl; negm[r] = -mhat; }
                const float f = __builtin_amdgcn_exp2f(-dl); lsum *= f;
                if (hi == 0) wsf[r32] = f;
#pragma unroll
                for (int r = 0; r < 16; ++r) { const float fr = wsfh[(r & 3) + 8 * (r >> 2)];
#pragma unroll
                    for (int d = 0; d < NDV; ++d) o[d][r] *= fr; }
            }
            float sacc = 0.f;
#pragma unroll
            for (int r = 0; r < 16; ++r) { p0[r] = __builtin_amdgcn_exp2f(p0[r]); p1[r] = __builtin_amdgcn_exp2f(p1[r]); sacc += p0[r] + p1[r]; }
            lsum += sacc;
            u32x4 pw[4];
#pragma unroll
            for (int i = 0; i < 4; ++i) { pw[0][i] = cvtpk(p0[2 * i], p0[2 * i + 1]); pw[1][i] = cvtpk(p0[8 + 2 * i], p0[8 + 2 * i + 1]); pw[2][i] = cvtpk(p1[2 * i], p1[2 * i + 1]); pw[3][i] = cvtpk(p1[8 + 2 * i], p1[8 + 2 * i + 1]); }
            const lds_cptr vp = vp0 + slot * L::VS;
#pragma unroll
            for (int d = 0; d < NDV; ++d)
#pragma unroll
                for (int s = 0; s < 4; ++s) { const s16x4 lo = vtr(vp + d * 4096 + s * 1024), hh = vtr(vp + d * 4096 + s * 1024 + 512);
                    const bf16x8 vf = (bf16x8){lo[0], lo[1], lo[2], lo[3], hh[0], hh[1], hh[2], hh[3]};
                    o[d] = ATT_MFMA(__builtin_bit_cast(bf16x8, pw[s]), vf, o[d]); if (s == 3) __builtin_amdgcn_sched_barrier(0); }
        }
        slot = (slot == 2) ? 0 : slot + 1; slot2 = (slot2 == 2) ? 0 : slot2 + 1;
    }
    lsum = swap_add(lsum);
    if (hi == 0) wsf[32 + r32] = lsum;
    ATT_WAIT_BAR(0);
    ALAS bf16* stg = (ALAS bf16*)(lds + wid * (32 * DV * 2));
    ALAS bf16* stgh = stg + 4 * hi * DV + r32;
#pragma unroll
    for (int r = 0; r < 16; ++r) { const int oc = (r & 3) + 8 * (r >> 2); const float rl = 1.0f / wsfh[32 + oc];
#pragma unroll
        for (int d = 0; d < NDV; ++d) { const unsigned w = cvtpk(o[d][r] * rl, 0.f); stgh[oc * DV + d * 32] = (bf16)(w & 0xffffu); } }
    asm volatile("s_waitcnt lgkmcnt(0)" ::: "memory");
    constexpr int PPR = DV / 8, RPP = 64 / PPR;
    { const ALAS u32x4* sp = (const ALAS u32x4*)(stg + (lane / PPR) * DV + (lane % PPR) * 8);
      bf16* gp = Op + (size_t)(qw + lane / PPR) * opitch + (lane % PPR) * 8; const size_t gstep = (size_t)RPP * opitch;
#pragma unroll
      for (int i = 0; i < 32 / RPP; ++i) { const u32x4 v = sp[i * (RPP * DV / 8)]; *(u32x4*)(gp + i * gstep) = v; } }
    asm volatile("s_waitcnt vmcnt(0) lgkmcnt(0)\n\ts_barrier" ::: "memory");
#undef ATT_DMA_K
#undef ATT_DMA_V
}

constexpr int XPITCH = 1024, KVPITCH = 2048, X_WS = 132096;
__device__ __forceinline__ void cross_unit(ALAS unsigned char* lds, const bf16* Qp  , const bf16* Kp  , const bf16* Vp  , bf16* Op) {
    const int tid = threadIdx.x, lane = tid & 63, r32 = lane & 31, hi = lane >> 5; const int wid = __builtin_amdgcn_readfirstlane(tid >> 6);
    const unsigned lds0 = (unsigned)(uintptr_t)lds;
    ALAS float* wsf = (ALAS float*)(lds + X_WS) + wid * 64;
#define X_DMA_K(j, slot) do { _Pragma("unroll") for (int i_ = 0; i_ < 4; ++i_) { const int p_ = wid * 4 + i_; \
        glds16(Kp + (size_t)((j) * 64 + lane) * KVPITCH + p_ * 8, (unsigned)__builtin_amdgcn_readfirstlane(lds0 + (slot) * 32768 + p_ * 1024)); } } while (0)
#define X_DMA_V(j, slot) do { _Pragma("unroll") for (int i_ = 0; i_ < 4; ++i_) { const int p_ = wid * 4 + i_; \
        glds16(Vp + (size_t)((j) * 64 + 16 * (p_ & 3) + (lane >> 2)) * KVPITCH + (p_ >> 2) * 32 + (lane & 3) * 8, (unsigned)__builtin_amdgcn_readfirstlane(lds0 + (slot) * 32768 + p_ * 1024)); } } while (0)
    X_DMA_K(0, 0); X_DMA_K(1, 1);
    bf16x8 qr[16];
#pragma unroll
    for (int s = 0; s < 16; ++s) qr[s] = *(const bf16x8*)(Qp + (size_t)(wid * 32 + r32) * XPITCH + s * 16 + hi * 8);
    const lds_cptr kp0 = (lds_cptr)lds + hi * 1024 + r32 * 16;
    const lds_cptr vp0 = (lds_cptr)lds + ((lane >> 4) & 1) * 32 + (lane & 3) * 8 + (4 * hi + ((lane & 15) >> 2)) * 64;
    f32x16 p[4][2];
#define X_QK(j, slot) do { const lds_cptr kp = kp0 + (slot) * 32768; f32x16 a0 = f32x16{}, a1 = f32x16{}; \
        _Pragma("unroll") for (int s = 0; s < 16; ++s) { const bf16x8 k0 = *(const ALAS bf16x8*)(kp + s * 2048), k1 = *(const ALAS bf16x8*)(kp + s * 2048 + 512); \
            a0 = ATT_MFMA(k0, qr[s], a0); a1 = ATT_MFMA(k1, qr[s], a1); if ((s & 3) == 3) __builtin_amdgcn_sched_barrier(0); } p[j][0] = a0; p[j][1] = a1; } while (0)
    ATT_WAIT_BAR(4); X_DMA_K(2, 2); X_QK(0, 0);
    ATT_WAIT_BAR(4); X_DMA_K(3, 0); X_QK(1, 1);
    ATT_WAIT_BAR(4); X_DMA_V(0, 1); X_QK(2, 2);
    ATT_WAIT_BAR(4); X_DMA_V(1, 2); X_QK(3, 0);
    float rm = -3.0e38f;
#pragma unroll
    for (int j = 0; j < 4; ++j)
#pragma unroll
        for (int r = 0; r < 16; ++r) rm = __builtin_fmaxf(rm, __builtin_fmaxf(p[j][0][r], p[j][1][r]));
    rm = swap_max(rm);
    float lsum = 0.f; u32x4 pw[4][4];
#pragma unroll
    for (int j = 0; j < 4; ++j) {
#pragma unroll
        for (int r = 0; r < 16; ++r) { p[j][0][r] = __builtin_amdgcn_exp2f(p[j][0][r] - rm); p[j][1][r] = __builtin_amdgcn_exp2f(p[j][1][r] - rm); lsum += p[j][0][r] + p[j][1][r]; }
#pragma unroll
        for (int i = 0; i < 4; ++i) { pw[j][0][i] = cvtpk(p[j][0][2 * i], p[j][0][2 * i + 1]); pw[j][1][i] = cvtpk(p[j][0][8 + 2 * i], p[j][0][8 + 2 * i + 1]);
            pw[j][2][i] = cvtpk(p[j][1][2 * i], p[j][1][2 * i + 1]); pw[j][3][i] = cvtpk(p[j][1][8 + 2 * i], p[j][1][8 + 2 * i + 1]); }
    }
    lsum = swap_add(lsum);
    f32x16 o[8];
#pragma unroll
    for (int d = 0; d < 8; ++d) o[d] = f32x16{};
#define X_PV(j, slot) do { const lds_cptr vp = vp0 + (slot) * 32768; \
        _Pragma("unroll") for (int d = 0; d < 8; ++d) _Pragma("unroll") for (int s = 0; s < 4; ++s) { const s16x4 lo = vtr(vp + d * 4096 + s * 1024), hh = vtr(vp + d * 4096 + s * 1024 + 512); \
            const bf16x8 vf = (bf16x8){lo[0], lo[1], lo[2], lo[3], hh[0], hh[1], hh[2], hh[3]}; o[d] = ATT_MFMA(__builtin_bit_cast(bf16x8, pw[j][s]), vf, o[d]); if (s == 3) __builtin_amdgcn_sched_barrier(0); } } while (0)
    ATT_WAIT_BAR(4); X_DMA_V(2, 0); X_PV(0, 1);
    ATT_WAIT_BAR(4); X_DMA_V(3, 1); X_PV(1, 2);
    ATT_WAIT_BAR(4); X_PV(2, 0);
    ATT_WAIT_BAR(0); X_PV(3, 1);
    if (hi == 0) wsf[r32] = lsum;
    ATT_WAIT_BAR(0);
    ALAS bf16* stg = (ALAS bf16*)(lds + wid * 16384);
    ALAS bf16* stgh = stg + 4 * hi * 256 + r32; ALAS float* wsfh = wsf + 4 * hi;
#pragma unroll
    for (int r = 0; r < 16; ++r) { const int oc = (r & 3) + 8 * (r >> 2); const float rl = 1.0f / wsfh[oc];
#pragma unroll
        for (int d = 0; d < 8; ++d) { const unsigned w = cvtpk(o[d][r] * rl, 0.f); stgh[oc * 256 + d * 32] = (bf16)(w & 0xffffu); } }
    asm volatile("s_waitcnt lgkmcnt(0)" ::: "memory");
    { const ALAS u32x4* sp = (const ALAS u32x4*)(stg + (lane >> 5) * 256 + (lane & 31) * 8);
      bf16* gp = Op + (size_t)(wid * 32 + (lane >> 5)) * XPITCH + (lane & 31) * 8;
#pragma unroll
      for (int i = 0; i < 16; ++i) { const u32x4 v = sp[i * 64]; *(u32x4*)(gp + (size_t)i * 2 * XPITCH) = v; } }
    asm volatile("s_waitcnt vmcnt(0) lgkmcnt(0)\n\ts_barrier" ::: "memory");
#undef X_DMA_K
#undef X_DMA_V
#undef X_QK
#undef X_PV
}
}

#define GAS __attribute__((address_space(1)))
#define LAS __attribute__((address_space(3)))
typedef unsigned short bf16;
typedef unsigned v4u __attribute__((ext_vector_type(4)));
typedef float f32x4 __attribute__((ext_vector_type(4)));
typedef short bf16x8 __attribute__((ext_vector_type(8)));
typedef GAS unsigned gu32;
typedef GAS unsigned long long gu64;
#define RLX_AGENT __ATOMIC_RELAXED, __HIP_MEMORY_SCOPE_AGENT
#define LDS_WAIT() asm volatile("s_waitcnt lgkmcnt(0)" ::: "memory")
#define VM_WAIT() asm volatile("s_waitcnt vmcnt(0)" ::: "memory")
__device__ __forceinline__ unsigned long long rt() { return __builtin_amdgcn_s_memrealtime(); }
__device__ __forceinline__ unsigned f2bf(float f) { unsigned u = __builtin_bit_cast(unsigned, f); return (u + 0x7fffu + ((u >> 16) & 1u)) >> 16; }
__device__ __forceinline__ unsigned pk2(float lo, float hi) { return f2bf(lo) | (f2bf(hi) << 16); }
#define XB_TMO      128
#define XB_XCNT(j)  (256  + 64 * (j))
#define XB_XSUB(j)  (1280 + 64 * (j))
#define XB_XGEN(j)  (2304 + 64 * (j))
#define XB_TOP      3328
#define XB_TOPGEN   3392
#define XCD_BAR_WORDS 3456
#define XB_SPIN_CAP (1u << 18)

__device__ __forceinline__ unsigned xb_ld(unsigned* p)              { return __hip_atomic_load(p, __ATOMIC_RELAXED, __HIP_MEMORY_SCOPE_AGENT); }
__device__ __forceinline__ unsigned xb_add(unsigned* p, unsigned v) { return __hip_atomic_fetch_add(p, v, __ATOMIC_RELAXED, __HIP_MEMORY_SCOPE_AGENT); }
__device__ __forceinline__ unsigned xb_xcc_id() { return (unsigned)__builtin_amdgcn_s_getreg((3 << 11) | 20) & 0xFu; }
#define XB_SPIN(cond, bar) do { unsigned _sp = 0; while (cond) { __builtin_amdgcn_s_sleep(1); \
    if ((++_sp & 255u) == 0u) { if (xb_ld(&(bar)[XB_TMO])) break; if (_sp > XB_SPIN_CAP) { atomicAdd(&(bar)[XB_TMO], 1u); break; } } } } while (0)

struct XcdBarrier {
    unsigned* bar; unsigned x;
    volatile LAS unsigned* st;
};

__device__ __forceinline__ XcdBarrier xcd_barrier_post(unsigned* bar, volatile LAS unsigned* st) {
    XcdBarrier b; b.bar = bar; b.x = xb_xcc_id(); b.st = st;
    if (threadIdx.x == 0) (void)xb_add(&bar[XB_XCNT(b.x)], 1u);
    return b;
}
__device__ __forceinline__ void xcd_barrier_complete(unsigned* bar, unsigned x, unsigned& nloc, unsigned& nx) {
    const unsigned G = gridDim.x * gridDim.y * gridDim.z;
    unsigned sum, cnt, mine, sp = 0u;
    for (;;) {
        sum = 0u; cnt = 0u; mine = 0u;
#pragma unroll
        for (unsigned j = 0; j < 16; ++j) { const unsigned c = xb_ld(&bar[XB_XCNT(j)]); sum += c; cnt += (c > 0u) ? 1u : 0u; mine = (j == x) ? c : mine; }
        if (sum == G) break;
        __builtin_amdgcn_s_sleep(1);
        if ((++sp & 255u) == 0u) { if (xb_ld(&bar[XB_TMO])) break; if (sp > XB_SPIN_CAP) { atomicAdd(&bar[XB_TMO], 1u); break; } }
    }
    nloc = mine > 0u ? mine : 1u; nx = cnt > 0u ? cnt : 1u;
}

__device__ __forceinline__ void xcd_barrier(const XcdBarrier& b) {
    asm volatile("s_waitcnt vmcnt(0)" ::: "memory");
    __syncthreads();
    if (threadIdx.x == 0) {
        unsigned* bar = b.bar;
        __builtin_amdgcn_s_waitcnt(0);
        unsigned nloc = b.st[0], nx = b.st[1];
        if (nloc == 0u) { xcd_barrier_complete(bar, b.x, nloc, nx); b.st[0] = nloc; b.st[1] = nx; }
        const unsigned old = xb_add(&bar[XB_XSUB(b.x)], 1u);
        const unsigned gen = old / nloc;
        if (old + 1u == (gen + 1u) * nloc) {
            __builtin_amdgcn_fence(__ATOMIC_RELEASE, "agent");
            asm volatile("s_waitcnt vmcnt(0)" ::: "memory");
            const unsigned og = xb_add(&bar[XB_TOP], 1u);
            const unsigned tg = og / nx;
            if (og + 1u == (tg + 1u) * nx) xb_add(&bar[XB_TOPGEN], 1u);
            else XB_SPIN(xb_ld(&bar[XB_TOPGEN]) == tg, bar);
            __builtin_amdgcn_fence(__ATOMIC_ACQUIRE, "agent");
            xb_add(&bar[XB_XGEN(b.x)], 1u);
            asm volatile("s_waitcnt vmcnt(0)" ::: "memory");
        } else {
            XB_SPIN(xb_ld(&bar[XB_XGEN(b.x)]) == gen, bar);
            __builtin_amdgcn_fence(__ATOMIC_ACQUIRE, "agent");
            asm volatile("s_waitcnt vmcnt(0)" ::: "memory");
        }
    }
    __syncthreads();
}
constexpr int NWAVES = 8;
#ifndef MK_N_LAUNCHES
#define MK_N_LAUNCHES 1
#endif
constexpr int N_PHASES = 11;
constexpr int N_LAUNCHES = MK_N_LAUNCHES;
static_assert(N_LAUNCHES == 1 || N_LAUNCHES == N_PHASES, "MK_N_LAUNCHES is 1 or 11");

constexpr int BATCH = 8, SEQ = 2048, D = 1024, M = BATCH * SEQ, MEMLEN = 256, MM = BATCH * MEMLEN, FF = 2816, NIN = 3072;
constexpr float LOG2E = 1.4426950408889634f;
constexpr float QS_SELF = 0.125f * LOG2E, QS_CROSS = 0.0625f * LOG2E;
constexpr float EPS = 1e-6f;

constexpr size_t MiB = 1u << 20;
constexpr size_t WS_CTL = 0, CTL_ZERO_BYTES = 1 * MiB;
constexpr size_t WS_WIN = 1 * MiB, WS_WOUT = 7 * MiB, WS_WCQ = 9 * MiB, WS_WCKV = 11 * MiB, WS_WCO = 15 * MiB, WS_WGU = 17 * MiB, WS_WD = 28 * MiB;
constexpr size_t WS_BTAB = 34 * MiB, WS_SSQ1 = WS_BTAB + 64 * 1024, WS_SSQ2 = WS_SSQ1 + 256 * 1024;
constexpr size_t WS_MN = 35 * MiB, WS_CKV = 39 * MiB;
constexpr size_t WS_A = 47 * MiB;
constexpr size_t WS_B = 79 * MiB;
constexpr size_t WS_OA = 175 * MiB, WS_O12 = 191 * MiB, WS_CQ = 175 * MiB;
constexpr size_t WS_X1 = 223 * MiB, WS_END = 255 * MiB;
constexpr int CW_BAR = 4096;

constexpr int RING_OFF = 0, RING_BYTES = 131072;
constexpr int TAB_OFF = RING_BYTES;
constexpr int XWS_OFF = RING_BYTES + 1024;
constexpr int LDSCTL_OFF = RING_BYTES + 4096, MISC_OFF = LDSCTL_OFF + 320;
constexpr int LDS_BYTES = 147456;
static_assert(MISC_OFF + 128 <= LDS_BYTES, "LDS map");
static_assert(att::X_WS == XWS_OFF, "cross scratch offset");

__device__ const unsigned char T5_BUCKET[128] = {0, 1, 2, 3, 4, 5, 6, 7, 8, 9, 10, 11, 12, 13, 14, 15, 16, 16, 16, 17, 17, 18, 18, 18, 19, 19, 19, 20, 20, 20, 20, 21, 21, 21, 21, 22, 22, 22, 22, 22, 23, 23, 23, 23, 23, 23, 24, 24, 24, 24, 24, 24, 25, 25, 25, 25, 25, 25, 25, 26, 26, 26, 26, 26, 26, 26, 26, 27, 27, 27, 27, 27, 27, 27, 27, 27, 27, 28, 28, 28, 28, 28, 28, 28, 28, 28, 28, 29, 29, 29, 29, 29, 29, 29, 29, 29, 29, 29, 29, 30, 30, 30, 30, 30, 30, 30, 30, 30, 30, 30, 30, 30, 30, 31, 31, 31, 31, 31, 31, 31, 31, 31, 31, 31, 31, 31, 31, 31};

struct Frame {
    LAS unsigned char* lds;
    volatile LAS unsigned* MISC;
    gu32* ctl;
    int tid, lane, wave;
    int vcu, G;
};
__device__ __forceinline__ float wave_sum(float v) {
#pragma unroll
    for (int o = 1; o < 64; o <<= 1) v += __shfl_xor(v, o);
    return v;
}
__device__ __forceinline__ void p0_transpose_item(const float* W, int K, int N, bf16* WT, int dst_row0, LAS float* scr, int k0, int n0, int lane, int gmode, const float* g1, const float* g2, float cscale) {
#pragma unroll 8
    for (int i = 0; i < 32; ++i) { const int kk = 2 * i + (lane >> 5), k = k0 + kk;
        float gain = cscale; if (gmode == 1) gain *= g1[k]; else if (gmode == 2) gain *= (k < 512) ? g1[k] : 0.8f * g2[(k - 512) & 127];
        scr[kk * 33 + (lane & 31)] = W[(size_t)k * N + n0 + (lane & 31)] * gain; }
    LDS_WAIT(); asm volatile("" ::: "memory");
    const int c = lane & 7;
#pragma unroll
    for (int j = 0; j < 4; ++j) { const int n = (lane >> 3) + 8 * j; const LAS float* s = scr + (8 * c) * 33 + n;
        v4u o; o.x = pk2(s[0 * 33], s[1 * 33]); o.y = pk2(s[2 * 33], s[3 * 33]); o.z = pk2(s[4 * 33], s[5 * 33]); o.w = pk2(s[6 * 33], s[7 * 33]);
        *(GAS v4u*)(WT + (size_t)(dst_row0 + n) * K + k0 + 8 * c) = o; }
    LDS_WAIT(); asm volatile("" ::: "memory");
}
__device__ __forceinline__ void rms_row_to_bf16(int lane, const float* xrow, const float* g, bf16* orow) {
    const GAS f32x4* xr = (const GAS f32x4*)xrow + lane; const GAS f32x4* gr = (const GAS f32x4*)g + lane;
    f32x4 v[4]; float s = 0.f;
#pragma unroll
    for (int j = 0; j < 4; ++j) { v[j] = xr[64 * j]; s += (v[j].x * v[j].x + v[j].y * v[j].y) + (v[j].z * v[j].z + v[j].w * v[j].w); }
    const float rstd = 1.f / sqrtf(wave_sum(s) * (1.f / 1024.f) + EPS);
    GAS unsigned long long* o8 = (GAS unsigned long long*)orow + lane;
#pragma unroll
    for (int j = 0; j < 4; ++j) { const f32x4 gg = gr[64 * j];
        o8[64 * j] = (unsigned long long)pk2(v[j].x * rstd * gg.x, v[j].y * rstd * gg.y) | ((unsigned long long)pk2(v[j].z * rstd * gg.z, v[j].w * rstd * gg.w) << 32); }
}

struct Args { const float* in[20]; float* out; unsigned char* ws; int ph_lo, ph_hi, li, pad; };
enum { I_X = 0, I_MEM, I_MIXG, I_WIN, I_MOBAG, I_LAMBDA, I_SUBLNG, I_WOUT, I_RELB, I_CROSSG, I_MEMG, I_WCQ, I_WCK, I_WCV, I_WCO, I_FFNG, I_WGATE, I_WUP, I_WDOWN, I_FINALG };

__global__ void __launch_bounds__(NWAVES * 64, 2) mk_fwd(Args args) {
    extern __shared__ __attribute__((aligned(16))) unsigned char lds[];
    Frame F;
    F.lds = (LAS unsigned char*)lds;
    F.MISC = (volatile LAS unsigned*)(F.lds + MISC_OFF);
    F.tid = threadIdx.x; F.lane = F.tid & 63; F.wave = __builtin_amdgcn_readfirstlane(F.tid >> 6);
    F.G = gridDim.x; { const int bx = blockIdx.x; F.vcu = (F.G % 8 == 0) ? (bx % 8) * (F.G / 8) + bx / 8 : bx; }
    unsigned char* ws = args.ws;
    F.ctl = (gu32*)(ws + WS_CTL);
    for (int u = F.tid; u < (LDS_BYTES - LDSCTL_OFF) / 4; u += NWAVES * 64) ((LAS unsigned*)(F.lds + LDSCTL_OFF))[u] = 0u;
    __syncthreads();
    XcdBarrier bar; bar.bar = (unsigned*)(F.ctl + CW_BAR); bar.x = 0; bar.st = nullptr;
    if (N_LAUNCHES == 1) bar = xcd_barrier_post((unsigned*)(F.ctl + CW_BAR), F.MISC + 8);
#define GRID_BAR() do { if (N_LAUNCHES == 1) xcd_barrier(bar); } while (0)
    const int lo = args.ph_lo, hi = args.ph_hi;
#ifndef PH_MASK
#define PH_MASK 0x7ff
#endif
#define IN(k) (((PH_MASK >> (k)) & 1) && lo <= (k) && (k) < hi)
#define BOTH(k) (IN(k) && IN((k) + 1))
#define PHASE_PTRS unsigned char* w_ = ws; asm volatile("" : "+s"(w_)); \
        bf16* const WIN = (bf16*)(w_ + WS_WIN); bf16* const WOUT = (bf16*)(w_ + WS_WOUT); bf16* const WCQ = (bf16*)(w_ + WS_WCQ); bf16* const WCKV = (bf16*)(w_ + WS_WCKV); \
        bf16* const WCO = (bf16*)(w_ + WS_WCO); bf16* const WGU = (bf16*)(w_ + WS_WGU); bf16* const WD = (bf16*)(w_ + WS_WD); \
        float* const BTAB = (float*)(w_ + WS_BTAB); float* const SSQ1 = (float*)(w_ + WS_SSQ1); float* const SSQ2 = (float*)(w_ + WS_SSQ2); \
        bf16* const MN = (bf16*)(w_ + WS_MN); bf16* const CKV = (bf16*)(w_ + WS_CKV); \
        bf16* const XN = (bf16*)(w_ + WS_A); bf16* const MIXED = (bf16*)(w_ + WS_A); bf16* const CO = (bf16*)(w_ + WS_A); \
        bf16* const PROJ = (bf16*)(w_ + WS_B); bf16* const HB = (bf16*)(w_ + WS_B); \
        bf16* const OA = (bf16*)(w_ + WS_OA); bf16* const O12 = (bf16*)(w_ + WS_O12); bf16* const CQ = (bf16*)(w_ + WS_CQ); \
        bf16* const X1 = (bf16*)(w_ + WS_X1); \
        (void)WIN; (void)WOUT; (void)WCQ; (void)WCKV; (void)WCO; (void)WGU; (void)WD; (void)BTAB; (void)SSQ1; (void)SSQ2; (void)MN; (void)CKV; (void)XN; (void)MIXED; (void)CO; (void)PROJ; (void)HB; (void)OA; (void)O12; (void)CQ; (void)X1;
    const int gw = F.vcu * NWAVES + F.wave, NGW = F.G * NWAVES;

    if (IN(0)) {
        PHASE_PTRS
        LAS float* scr = (LAS float*)(F.lds + RING_OFF + F.wave * 16384);
        constexpr int I0 = 16 * 96, I1 = 512, I6 = 16 * 88, I8 = 44 * 32;
        constexpr int NITEMS = I0 + 5 * I1 + 2 * I6 + I8;
        for (int it = gw; it < NITEMS; it += NGW) {
            int r = it;
            if (r < I0) { const int kb = r / 96, nb = r % 96, n0 = nb * 32; const float cs = (n0 < 512 || (n0 >= 1536 && n0 < 2048)) ? QS_SELF : 1.f;
                p0_transpose_item(args.in[I_WIN], 1024, 3072, WIN, n0, scr, kb * 64, n0, F.lane, 0, nullptr, nullptr, cs); continue; } r -= I0;
            if (r < I1) { const int kb = r / 32, n0 = (r % 32) * 32; p0_transpose_item(args.in[I_WOUT], 1024, 1024, WOUT, n0, scr, kb * 64, n0, F.lane, 2, args.in[I_MOBAG], args.in[I_SUBLNG], 1.f); continue; } r -= I1;
            if (r < I1) { const int kb = r / 32, n0 = (r % 32) * 32; p0_transpose_item(args.in[I_WCQ], 1024, 1024, WCQ, n0, scr, kb * 64, n0, F.lane, 1, args.in[I_CROSSG], nullptr, QS_CROSS); continue; } r -= I1;
            if (r < I1) { const int kb = r / 32, n0 = (r % 32) * 32; p0_transpose_item(args.in[I_WCK], 1024, 1024, WCKV, n0, scr, kb * 64, n0, F.lane, 0, nullptr, nullptr, 1.f); continue; } r -= I1;
            if (r < I1) { const int kb = r / 32, n0 = (r % 32) * 32; p0_transpose_item(args.in[I_WCV], 1024, 1024, WCKV, 1024 + n0, scr, kb * 64, n0, F.lane, 0, nullptr, nullptr, 1.f); continue; } r -= I1;
            if (r < I1) { const int kb = r / 32, n0 = (r % 32) * 32; p0_transpose_item(args.in[I_WCO], 1024, 1024, WCO, n0, scr, kb * 64, n0, F.lane, 0, nullptr, nullptr, 1.f); continue; } r -= I1;
            if (r < I6) { const int kb = r / 88, n0 = (r % 88) * 32; p0_transpose_item(args.in[I_WGATE], 1024, FF, WGU, 256 * (n0 >> 7) + (n0 & 127), scr, kb * 64, n0, F.lane, 1, args.in[I_FFNG], nullptr, 1.f); continue; } r -= I6;
            if (r < I6) { const int kb = r / 88, n0 = (r % 88) * 32; p0_transpose_item(args.in[I_WUP], 1024, FF, WGU, 256 * (n0 >> 7) + 128 + (n0 & 127), scr, kb * 64, n0, F.lane, 1, args.in[I_FFNG], nullptr, 1.f); continue; } r -= I6;
            { const int kb = r / 32, n0 = (r % 32) * 32; p0_transpose_item(args.in[I_WDOWN], FF, 1024, WD, n0, scr, kb * 64, n0, F.lane, 0, nullptr, nullptr, 1.f); }
        }
        for (int m = gw; m < M + MM; m += NGW) {
            if (m < M) rms_row_to_bf16(F.lane, args.in[I_X] + (size_t)m * D, args.in[I_MIXG], XN + (size_t)m * D);
            else rms_row_to_bf16(F.lane, args.in[I_MEM] + (size_t)(m - M) * D, args.in[I_MEMG], MN + (size_t)(m - M) * D);
        }
        { const int gt = F.vcu * NWAVES * 64 + F.tid;
          if (gt < 12 * 132) { const int h = gt / 132, d = gt % 132; const float* T = args.in[I_RELB];
              BTAB[gt] = (d < 128) ? (T[T5_BUCKET[d] * 12 + h] - T[31 * 12 + h]) * LOG2E : 0.f; } }
        if (BOTH(0)) GRID_BAR();
    }

    if (IN(1)) {
        PHASE_PTRS
        pg8::Gemm g{XN, WIN, M, NIN, D}; pg8::StaticOrder S; S.init(M, NIN, F.G, (int)blockIdx.x);
        pg8::EpiStore E{PROJ, NIN, nullptr};
        pg8::gemm_phase<pg8::EpiStore, pg8::StaticOrder, true, true>(F.lds + RING_OFF, g, S, E);
        if (BOTH(1)) GRID_BAR();
    }

    if (IN(2)) {
        PHASE_PTRS
        LAS float* tab = (LAS float*)(F.lds + TAB_OFF);
        for (int p = F.vcu; p < 256; p += F.G) {
#ifndef SKIP_MOBA
            { const int bh = p >> 2, b = bh >> 3, h = bh & 7, s = p & 3;
              if (F.tid < 132) tab[F.tid] = BTAB[h * 132 + F.tid];
              const bf16* base = PROJ + (size_t)b * SEQ * NIN;
#pragma unroll 1
              for (int i = 0; i < 2; ++i) { const int qb = i == 0 ? 7 - s : s;
                  att::self_unit<64, true>(F.lds + RING_OFF, base + h * 64, base + 512 + h * 64, base + 1024 + h * 64, OA + (size_t)b * SEQ * 512 + h * 64, 512, qb, tab); } }
#endif
#ifndef SKIP_DIFF
            { const int idx = p >> 2, b = idx >> 3, h = (idx >> 1) & 3, mp = idx & 1, s = p & 3;
              if (F.tid < 132) tab[F.tid] = BTAB[(8 + h) * 132 + F.tid];
              const bf16* base = PROJ + (size_t)b * SEQ * NIN;
#pragma unroll 1
              for (int i = 0; i < 2; ++i) { const int qb = i == 0 ? 7 - s : s;
                  att::self_unit<128, false>(F.lds + RING_OFF, base + 1536 + h * 128 + mp * 64, base + 2048 + h * 128 + mp * 64, base + 2560 + h * 128, O12 + (size_t)b * SEQ * 1024 + h * 256 + mp * 128, 1024, qb, tab); } }
#endif
        }
        if (BOTH(2)) GRID_BAR();
    }

    if (IN(3)) {
        PHASE_PTRS
        const float* lp = args.in[I_LAMBDA];
        const float s1 = wave_sum(lp[F.lane] * lp[64 + F.lane]), s2 = wave_sum(lp[128 + F.lane] * lp[192 + F.lane]);
        const float lam = expf(s1) - expf(s2) + 0.2f;
        for (int m = gw; m < M; m += NGW) {
            const int L = F.lane;
            { const bf16x8 v = *(const GAS bf16x8*)(OA + (size_t)m * 512 + L * 8); float f[8]; float ss = 0.f;
#pragma unroll
              for (int j = 0; j < 8; ++j) { f[j] = att::bf2f(v[j]); ss += f[j] * f[j]; }
              const float rstd = 1.f / sqrtf(wave_sum(ss) * (1.f / 512.f) + EPS);
              v4u o; o.x = pk2(f[0] * rstd, f[1] * rstd); o.y = pk2(f[2] * rstd, f[3] * rstd); o.z = pk2(f[4] * rstd, f[5] * rstd); o.w = pk2(f[6] * rstd, f[7] * rstd);
              *(GAS v4u*)(MIXED + (size_t)m * D + L * 8) = o; }
            { const int h = L >> 4, dd = (L & 15) * 8;
              const bf16x8 a = *(const GAS bf16x8*)(O12 + (size_t)m * 1024 + h * 256 + dd), b = *(const GAS bf16x8*)(O12 + (size_t)m * 1024 + h * 256 + 128 + dd); float f[8]; float ss = 0.f;
#pragma unroll
              for (int j = 0; j < 8; ++j) { f[j] = att::bf2f(a[j]) - lam * att::bf2f(b[j]); ss += f[j] * f[j]; }
              ss += __shfl_xor(ss, 1); ss += __shfl_xor(ss, 2); ss += __shfl_xor(ss, 4); ss += __shfl_xor(ss, 8);
              const float rstd = 1.f / sqrtf(ss * (1.f / 128.f) + EPS);
              v4u o; o.x = pk2(f[0] * rstd, f[1] * rstd); o.y = pk2(f[2] * rstd, f[3] * rstd); o.z = pk2(f[4] * rstd, f[5] * rstd); o.w = pk2(f[6] * rstd, f[7] * rstd);
              *(GAS v4u*)(MIXED + (size_t)m * D + 512 + h * 128 + dd) = o; }
        }
        if (BOTH(3)) GRID_BAR();
    }

    if (IN(4)) {
        PHASE_PTRS
        pg8::Gemm g{MIXED, WOUT, M, D, D}; pg8::StaticOrder S; S.init(M, D, F.G, (int)blockIdx.x);
        pg8::EpiResid<true, false> E{args.in[I_X], X1, SSQ1, D};
        pg8::gemm_phase<pg8::EpiResid<true, false>, pg8::StaticOrder, false, true>(F.lds + RING_OFF, g, S, E);
        if (BOTH(4)) GRID_BAR();
    }

    if (IN(5)) {
        PHASE_PTRS
        { pg8::Gemm g{X1, WCQ, M, D, D}; pg8::StaticOrder S; S.init(M, D, F.G, (int)blockIdx.x);
          pg8::EpiStore E{CQ, D, SSQ1};
          pg8::gemm_phase<pg8::EpiStore, pg8::StaticOrder, true, true>(F.lds + RING_OFF, g, S, E); }
        { pg8::Gemm g{MN, WCKV, MM, 2 * D, D}; pg8::StaticOrder S; S.init(MM, 2 * D, F.G, (int)blockIdx.x);
          pg8::EpiStore E{CKV, 2 * D, nullptr};
          pg8::gemm_phase<pg8::EpiStore, pg8::StaticOrder, true, true>(F.lds + RING_OFF, g, S, E); }
        if (BOTH(5)) GRID_BAR();
    }

    if (IN(6)) {
        PHASE_PTRS
        for (int p = F.vcu; p < 256; p += F.G) { const int b = p >> 5, h = (p >> 3) & 3, qb = p & 7;
            att::cross_unit(F.lds + RING_OFF, CQ + (size_t)(b * SEQ + qb * 256) * D + h * 256, CKV + (size_t)(b * MEMLEN) * 2048 + h * 256, CKV + (size_t)(b * MEMLEN) * 2048 + 1024 + h * 256,
                            CO + (size_t)(b * SEQ + qb * 256) * D + h * 256); }
        if (BOTH(6)) GRID_BAR();
    }

    if (IN(7)) {
        PHASE_PTRS
        pg8::Gemm g{CO, WCO, M, D, D}; pg8::StaticOrder S; S.init(M, D, F.G, (int)blockIdx.x);
        pg8::EpiResid<false, false> E{X1, X1, SSQ2, D};
        pg8::gemm_phase<pg8::EpiResid<false, false>, pg8::StaticOrder, false, true>(F.lds + RING_OFF, g, S, E);
        if (BOTH(7)) GRID_BAR();
    }

    if (IN(8)) {
        PHASE_PTRS
        pg8::Gemm g{X1, WGU, M, 2 * FF, D}; pg8::StaticOrder S; S.init(M, 2 * FF, F.G, (int)blockIdx.x);
        pg8::EpiSwiGLU E{HB, FF, SSQ2};
        pg8::gemm_phase<pg8::EpiSwiGLU, pg8::StaticOrder, true, true>(F.lds + RING_OFF, g, S, E);
        if (BOTH(8)) GRID_BAR();
    }

    if (IN(9)) {
        PHASE_PTRS
        pg8::Gemm g{HB, WD, M, D, FF}; pg8::StaticOrder S; S.init(M, D, F.G, (int)blockIdx.x);
        pg8::EpiResid<false, true> E{X1, args.out, nullptr, D};
        pg8::gemm_phase<pg8::EpiResid<false, true>, pg8::StaticOrder, false, true>(F.lds + RING_OFF, g, S, E);
        if (BOTH(9)) GRID_BAR();
    }

    if (IN(10)) {
        PHASE_PTRS
        const GAS f32x4* gr = (const GAS f32x4*)args.in[I_FINALG] + F.lane;
        f32x4 gg[4];
#pragma unroll
        for (int j = 0; j < 4; ++j) gg[j] = gr[64 * j];
        for (int m = gw; m < M; m += NGW) {
            GAS f32x4* xr = (GAS f32x4*)(args.out + (size_t)m * D) + F.lane;
            f32x4 v[4]; float s = 0.f;
#pragma unroll
            for (int j = 0; j < 4; ++j) { v[j] = xr[64 * j]; s += (v[j].x * v[j].x + v[j].y * v[j].y) + (v[j].z * v[j].z + v[j].w * v[j].w); }
            const float rstd = 1.f / sqrtf(wave_sum(s) * (1.f / 1024.f) + EPS);
#pragma unroll
            for (int j = 0; j < 4; ++j) xr[64 * j] = v[j] * rstd * gg[j];
        }
    }
#undef IN
#undef BOTH
#undef GRID_BAR
}

extern "C" void kernel_launch(void* const* d_in, const int* in_sizes, int n_in, void* d_out, int out_size, void* d_ws, size_t ws_size, hipStream_t stream) {
    static int grid = 0;
    if (grid == 0) {
        if (n_in != 20 || in_sizes[0] != M * D || out_size != M * D || ws_size < WS_END) { fprintf(stderr, "kernel_launch: unexpected shapes (n_in %d, in0 %d, out %d, ws %zu); nothing launched\n", n_in, n_in > 0 ? in_sizes[0] : -1, out_size, ws_size); grid = -1; return; }
        int dev = 0, cus = 0, per_cu = 0;
        if (hipGetDevice(&dev) != hipSuccess || hipDeviceGetAttribute(&cus, hipDeviceAttributeMultiprocessorCount, dev) != hipSuccess) { grid = -1; return; }
        if (hipFuncSetAttribute((const void*)mk_fwd, hipFuncAttributeMaxDynamicSharedMemorySize, LDS_BYTES) != hipSuccess) { fprintf(stderr, "kernel_launch: hipFuncSetAttribute failed\n"); grid = -1; return; }
        if (hipOccupancyMaxActiveBlocksPerMultiprocessor(&per_cu, (const void*)mk_fwd, NWAVES * 64, LDS_BYTES) != hipSuccess || per_cu < 1) { fprintf(stderr, "kernel_launch: occupancy query says %d workgroups per CU; nothing launched\n", per_cu); (void)hipGetLastError(); grid = -1; return; }
        (void)hipGetLastError();
        grid = cus;
        if (grid != 256) { fprintf(stderr, "kernel_launch: built for 256 CUs, found %d; nothing launched\n", cus); grid = -1; return; }
    }
    if (grid < 0) return;
    if (hipMemsetAsync((char*)d_ws + WS_CTL, 0, CTL_ZERO_BYTES, stream) != hipSuccess) return;
    Args a{};
    for (int i = 0; i < 20; ++i) a.in[i] = (const float*)d_in[i];
    a.out = (float*)d_out; a.ws = (unsigned char*)d_ws;
    for (int li = 0; li < N_LAUNCHES; ++li) {
        a.ph_lo = (N_LAUNCHES == 1) ? 0 : li; a.ph_hi = (N_LAUNCHES == 1) ? N_PHASES : li + 1; a.li = li; a.pad = 0;
        hipLaunchKernelGGL(mk_fwd, dim3(grid), dim3(NWAVES * 64), LDS_BYTES, stream, a);
    }
}
```

```cpp
#include <hip/hip_runtime.h>
#include <hip/hip_bf16.h>
#include <cstdio>
#include <cstdint>
namespace pg8 {
#define PG8_LAS __attribute__((address_space(3)))
typedef unsigned short bf16_t;
typedef short bf16x8 __attribute__((ext_vector_type(8)));
typedef float f32x4 __attribute__((ext_vector_type(4)));
typedef unsigned u32x4 __attribute__((ext_vector_type(4)));
constexpr int BM = 256, BK = 64, HALF = 128, HTB = HALF * BK * 2  , STAGE_BYTES = 8 * HTB, NXCD = 8, WGM = 8;

__host__ __device__ __forceinline__ int lds_byte(int r, int c) { const int st = (r >> 4) * 2 + (c >> 5), rr = r & 15, cc = c & 31, ob = rr * 64 + cc * 2; return st * 1024 + (ob ^ (((ob >> 9) & 1) << 5)); }
__host__ __device__ __forceinline__ void stage_rc(int b, int& R, int& C) { const int st = b / 1024, sb = b % 1024, swz = sb ^ (((sb >> 9) & 1) << 5); R = (st >> 1) * 16 + swz / 64; C = (st & 1) * 32 + (swz % 64) / 2; }
__host__ __device__ __forceinline__ int perm32(int rho) { const int n = rho >> 4, i = rho & 15; return 8 * (i >> 2) + 4 * n + (i & 3); }

struct Unit { int pm, pn; };
struct Gemm { const bf16_t* A; const bf16_t* Bt; int M, N, K; };

struct StaticOrder {
    int nM, nN, nwg, G, c;
    __host__ __device__ void init(int M, int N, int G_, int c_) { nM = M / BM; nN = N / BM; nwg = nM * nN; G = G_; c = c_; }
    __host__ __device__ bool next(int i, Unit& u) const {
        const long L = (long)i * G + c; if (L >= nwg) return false;
        int wgid = (int)L; { const int q = nwg / NXCD, r = nwg % NXCD, xcd = wgid % NXCD, off = wgid / NXCD; wgid = (xcd < r ? xcd * (q + 1) : r * (q + 1) + (xcd - r) * q) + off; }
        const int nig = WGM * nN, gid = wgid / nig, fm = gid * WGM, gsz = (nM - fm) < WGM ? (nM - fm) : WGM;
        u.pm = fm + ((wgid % nig) % gsz); u.pn = (wgid % nig) / gsz; return true;
    }
    __device__ __forceinline__ void a_ready(const Unit&) const {}
    __device__ __forceinline__ void done(const Unit&) const {}
};

__device__ __forceinline__ unsigned cvt_pk_bf16(float lo, float hi) { unsigned r; asm volatile("v_cvt_pk_bf16_f32 %0, %1, %2" : "=v"(r) : "v"(lo), "v"(hi)); return r; }
typedef float f32x2 __attribute__((ext_vector_type(2)));
typedef unsigned u32x2v __attribute__((ext_vector_type(2)));
__device__ __forceinline__ float bf_lo(unsigned w) { return __uint_as_float(w << 16); }
__device__ __forceinline__ float bf_hi(unsigned w) { return __uint_as_float(w & 0xffff0000u); }
__device__ __forceinline__ float row_rstd(const float* ssq, int row) { const f32x4 s = *(const f32x4*)(ssq + (size_t)row * 4); return 1.0f / sqrtf(((s[0] + s[1]) + (s[2] + s[3])) * (1.0f / 1024.0f) + 1e-6f); }

struct EpiStore {
    static constexpr bool PERM = true, AFTER_DRAIN = false;
    bf16_t* O; int ldc; const float* ssq;
    __device__ __forceinline__ void operator()(const f32x4 (&acc)[2][2][4][2], const Unit& u, int wr, int wc, int fr, int fq) const {
        const int row0 = u.pm * BM + wr * 64 + fr, col0 = u.pn * BM + wc * 32 + 8 * fq;
#pragma unroll
        for (int ai = 0; ai < 2; ++ai)
#pragma unroll
            for (int m = 0; m < 4; ++m) { const int row = row0 + ai * HALF + m * 16; const float sc = ssq ? row_rstd(ssq, row) : 1.0f; bf16_t* rowp = O + (size_t)row * ldc + col0;
#pragma unroll
                for (int bj = 0; bj < 2; ++bj) { const f32x4 v0 = acc[ai][bj][m][0] * sc, v1 = acc[ai][bj][m][1] * sc;
                    u32x4 w; w.x = cvt_pk_bf16(v0[0], v0[1]); w.y = cvt_pk_bf16(v0[2], v0[3]); w.z = cvt_pk_bf16(v1[0], v1[1]); w.w = cvt_pk_bf16(v1[2], v1[3]);
                    *(u32x4*)(rowp + bj * HALF) = w; } }
    }
};
struct EpiProj {
    static constexpr bool PERM = true, AFTER_DRAIN = false;
    bf16_t* O; int ldc; float* kn; float* ks;
    __device__ __forceinline__ void operator()(const f32x4 (&acc)[2][2][4][2], const Unit& u, int wr, int wc, int fr, int fq) const {
        const int row0 = u.pm * BM + wr * 64 + fr, col0 = u.pn * BM + wc * 32 + 8 * fq;
        const bool wantn = (u.pn == 2) | (u.pn == 3) | (u.pn == 8) | (u.pn == 9), wants = (u.pn == 2) | (u.pn == 3);
        float mx[2] = {0.f, 0.f}; f32x4 cs[2][2];
#pragma unroll
        for (int bj = 0; bj < 2; ++bj) { cs[bj][0] = (f32x4){0.f, 0.f, 0.f, 0.f}; cs[bj][1] = (f32x4){0.f, 0.f, 0.f, 0.f}; }
#pragma unroll
        for (int ai = 0; ai < 2; ++ai)
#pragma unroll
            for (int m = 0; m < 4; ++m) { const int row = row0 + ai * HALF + m * 16; bf16_t* rowp = O + (size_t)row * ldc + col0;
#pragma unroll
                for (int bj = 0; bj < 2; ++bj) { const f32x4 v0 = acc[ai][bj][m][0], v1 = acc[ai][bj][m][1];
                    u32x4 w; w.x = cvt_pk_bf16(v0[0], v0[1]); w.y = cvt_pk_bf16(v0[2], v0[3]); w.z = cvt_pk_bf16(v1[0], v1[1]); w.w = cvt_pk_bf16(v1[2], v1[3]);
                    *(u32x4*)(rowp + bj * HALF) = w;
                    if (wantn) { float hs = (v0[0] * v0[0] + v0[1] * v0[1]) + (v0[2] * v0[2] + v0[3] * v0[3]) + (v1[0] * v1[0] + v1[1] * v1[1]) + (v1[2] * v1[2] + v1[3] * v1[3]);
                        hs += __shfl_xor(hs, 16); hs += __shfl_xor(hs, 32); mx[bj] = __builtin_fmaxf(mx[bj], hs); }
                    if (wants) { cs[bj][0] += v0; cs[bj][1] += v1; } } }
        if (wantn) {
#pragma unroll
            for (int bj = 0; bj < 2; ++bj) { float v = mx[bj]; v = __builtin_fmaxf(v, __shfl_xor(v, 1)); v = __builtin_fmaxf(v, __shfl_xor(v, 2)); v = __builtin_fmaxf(v, __shfl_xor(v, 4)); v = __builtin_fmaxf(v, __shfl_xor(v, 8));
                if (fr == 0 && fq == 0) kn[((size_t)(u.pm * 12 + u.pn) * 8 + wr * 4 + wc) * 2 + bj] = v; }
        }
        if (wants) {
#pragma unroll
            for (int bj = 0; bj < 2; ++bj)
#pragma unroll
                for (int n = 0; n < 2; ++n) { f32x4 v = cs[bj][n];
#pragma unroll
                    for (int i = 0; i < 4; ++i) { float x = v[i]; x += __shfl_xor(x, 1); x += __shfl_xor(x, 2); x += __shfl_xor(x, 4); x += __shfl_xor(x, 8); v[i] = x; }
                    if (fr == 0) *(f32x4*)(ks + ((size_t)(u.pm * 12 + u.pn) * 2 + wr) * 256 + bj * HALF + wc * 32 + 8 * fq + 4 * n) = v; }
        }
    }
};
struct EpiSwiGLU {
    static constexpr bool PERM = true, AFTER_DRAIN = false;
    bf16_t* H; int ldh; const float* ssq;
    __device__ __forceinline__ void operator()(const f32x4 (&acc)[2][2][4][2], const Unit& u, int wr, int wc, int fr, int fq) const {
        const int row0 = u.pm * BM + wr * 64 + fr, col0 = u.pn * HALF + wc * 32 + 8 * fq;
#pragma unroll
        for (int ai = 0; ai < 2; ++ai)
#pragma unroll
            for (int m = 0; m < 4; ++m) { const int row = row0 + ai * HALF + m * 16; const float sc = row_rstd(ssq, row);
                float h[8];
#pragma unroll
                for (int n = 0; n < 2; ++n)
#pragma unroll
                    for (int i = 0; i < 4; ++i) { const float g = acc[ai][0][m][n][i] * sc, up = acc[ai][1][m][n][i] * sc;
                        const float e = __builtin_amdgcn_exp2f(g * -1.4426950408889634f);
                        h[n * 4 + i] = g * up * __builtin_amdgcn_rcpf(1.0f + e); }
                u32x4 w; w.x = cvt_pk_bf16(h[0], h[1]); w.y = cvt_pk_bf16(h[2], h[3]); w.z = cvt_pk_bf16(h[4], h[5]); w.w = cvt_pk_bf16(h[6], h[7]);
                *(u32x4*)(H + (size_t)row * ldh + col0) = w; }
    }
};
template <bool RES_F32, bool OUT_F32> struct EpiResid {
    static constexpr bool PERM = true, AFTER_DRAIN = true;
    const void* resid; void* out; float* ssq; int ld;
    __device__ __forceinline__ void fused(f32x4 (&acc)[2][2][4][2], const Unit& u, int wr, int wc, int fr, int fq, PG8_LAS unsigned char* lds, int wid, int lane) const {
        PG8_LAS float* P = (PG8_LAS float*)lds;
        const int col0 = u.pn * BM + wc * 32 + 8 * fq;
#pragma unroll
        for (int ai = 0; ai < 2; ++ai)
#pragma unroll
            for (int m = 0; m < 4; ++m) { const int rl = ai * HALF + wr * 64 + m * 16 + fr; const size_t off = (size_t)(u.pm * BM + rl) * ld + col0; float s = 0.f;
#pragma unroll
                for (int bj = 0; bj < 2; ++bj) { f32x4 v0 = acc[ai][bj][m][0], v1 = acc[ai][bj][m][1];
                    if (RES_F32) { const float* rp = (const float*)resid + off + bj * HALF; v0 += *(const f32x4*)rp; v1 += *(const f32x4*)(rp + 4); }
                    else { const u32x4 rw = *(const u32x4*)((const bf16_t*)resid + off + bj * HALF);
                        v0 += (f32x4){bf_lo(rw.x), bf_hi(rw.x), bf_lo(rw.y), bf_hi(rw.y)}; v1 += (f32x4){bf_lo(rw.z), bf_hi(rw.z), bf_lo(rw.w), bf_hi(rw.w)}; }
                    s += (v0[0] * v0[0] + v0[1] * v0[1]) + (v0[2] * v0[2] + v0[3] * v0[3]) + (v1[0] * v1[0] + v1[1] * v1[1]) + (v1[2] * v1[2] + v1[3] * v1[3]);
                    if (OUT_F32) { float* op = (float*)out + off + bj * HALF; *(f32x4*)op = v0; *(f32x4*)(op + 4) = v1; }
                    else { u32x4 w; w.x = cvt_pk_bf16(v0[0], v0[1]); w.y = cvt_pk_bf16(v0[2], v0[3]); w.z = cvt_pk_bf16(v1[0], v1[1]); w.w = cvt_pk_bf16(v1[2], v1[3]);
                        *(u32x4*)((bf16_t*)out + off + bj * HALF) = w; } }
                s += __shfl_xor(s, 16); s += __shfl_xor(s, 32);
                if (ssq != nullptr && fq == 0) P[rl * 4 + wc] = s; }
        if (ssq != nullptr) {
            asm volatile("s_waitcnt lgkmcnt(0)" ::: "memory"); __builtin_amdgcn_s_barrier(); asm volatile("" ::: "memory");
            const int t = wid * 64 + lane;
            if (t < 256) { const float a = P[t * 4 + 0], b = P[t * 4 + 1], c = P[t * 4 + 2], d = P[t * 4 + 3]; ssq[(size_t)(u.pm * BM + t) * 4 + u.pn] = (a + b) + (c + d); }
        }
    }
};

template <class Epi, class Sched, bool ALIGN_EPI = false, bool SP2 = false>
__device__ __forceinline__ void gemm_phase(PG8_LAS unsigned char* lds, const Gemm g, const Sched& S, const Epi& E) {
    const int tid = threadIdx.x, wid = __builtin_amdgcn_readfirstlane(tid >> 6), lane = tid & 63, wr = wid >> 2, wc = wid & 3, fr = lane & 15, fq = lane >> 4;
    const int K = g.K, nt = K / BK;
    unsigned voffA[2], voffB[2];
#pragma unroll
    for (int i = 0; i < 2; ++i) { int R, C; stage_rc(tid * 16 + i * 8192, R, C); const int Rb = Epi::PERM ? ((R & ~31) + perm32(R & 31)) : R;
        voffA[i] = (unsigned)(R * K + C) * 2u; voffB[i] = (unsigned)(Rb * K + C) * 2u; }
    const size_t kstep = (size_t)(BK * 2);
    const size_t hstep = (size_t)HALF * K * 2;
    const size_t tstep = 2 * hstep;
    const unsigned ldsw = (unsigned)wid * 1024u;
    const int aoff = lds_byte(wr * 64 + fr, fq * 8), boff = lds_byte(wc * 32 + fr, fq * 8);
#define PG8_SA(b, h) (((b) * 2 + (h)) * HTB)
#define PG8_SB(b, h) ((4 + (b) * 2 + (h)) * HTB)
#define PG8_STAGE(bufoff, gbase, voff) do { _Pragma("unroll") for (int _i = 0; _i < 2; ++_i) \
        __builtin_amdgcn_global_load_lds((const unsigned*)((const char*)(gbase) + (voff)[_i]), (PG8_LAS unsigned*)(lds + (bufoff) + ldsw + _i * 8192), 16, 0, 0); } while (0)
#define PG8_LDA(dst, b, h) do { _Pragma("unroll") for (int m = 0; m < 4; ++m) _Pragma("unroll") for (int k = 0; k < 2; ++k) dst[m][k] = *(const PG8_LAS bf16x8*)(lds + PG8_SA(b, h) + aoff + m * 2048 + k * 1024); } while (0)
#define PG8_LDB(dst, b, h) do { _Pragma("unroll") for (int n = 0; n < 2; ++n) _Pragma("unroll") for (int k = 0; k < 2; ++k) dst[n][k] = *(const PG8_LAS bf16x8*)(lds + PG8_SB(b, h) + boff + n * 2048 + k * 1024); } while (0)
#define PG8_MMA(ai, bj, At, Bt) do { __builtin_amdgcn_s_setprio(1); _Pragma("unroll") for (int m = 0; m < 4; ++m) _Pragma("unroll") for (int n = 0; n < 2; ++n) _Pragma("unroll") for (int k = 0; k < 2; ++k) \
        acc[ai][bj][m][n] = __builtin_amdgcn_mfma_f32_16x16x32_bf16(Bt[n][k], At[m][k], acc[ai][bj][m][n], 0, 0, 0); __builtin_amdgcn_s_setprio(0); } while (0)
#define PG8_WAIT_V(n) asm volatile("s_waitcnt vmcnt(" #n ")" ::: "memory")
#define PG8_WAIT_L(n) asm volatile("s_waitcnt lgkmcnt(" #n ")" ::: "memory")
#define PG8_BAR __builtin_amdgcn_s_barrier()
#define PG8_SCHED __builtin_amdgcn_sched_barrier(0)
    Unit cur, nxt; int ui = 0;
    if (!S.next(0, cur)) return;
    f32x4 acc[2][2][4][2];
#pragma unroll
    for (int a = 0; a < 2; ++a)
#pragma unroll
        for (int b = 0; b < 2; ++b)
#pragma unroll
            for (int m = 0; m < 4; ++m)
#pragma unroll
                for (int n = 0; n < 2; ++n) acc[a][b][m][n] = (f32x4){0.f, 0.f, 0.f, 0.f};
    bf16x8 At[4][2], B0[2][2], B1[2][2];
    const char* cA = (const char*)g.A + (size_t)cur.pm * tstep; const char* cB = (const char*)g.Bt + (size_t)cur.pn * tstep;
    S.a_ready(cur);
    if constexpr (SP2) {
        PG8_STAGE(PG8_SB(0, 0), cB, voffB); PG8_STAGE(PG8_SB(0, 1), cB + hstep, voffB); PG8_STAGE(PG8_SA(0, 0), cA, voffA); PG8_STAGE(PG8_SA(0, 1), cA + hstep, voffA);
        if (wr == 1) PG8_BAR;
        PG8_WAIT_V(2); PG8_BAR;
        PG8_STAGE(PG8_SB(1, 0), cB + kstep, voffB); PG8_STAGE(PG8_SA(1, 0), cA + kstep, voffA); PG8_STAGE(PG8_SB(1, 1), cB + hstep + kstep, voffB);
        PG8_WAIT_V(6); PG8_BAR;
    } else {
        PG8_STAGE(PG8_SB(0, 0), cB, voffB); PG8_STAGE(PG8_SA(0, 0), cA, voffA); PG8_STAGE(PG8_SB(0, 1), cB + hstep, voffB); PG8_STAGE(PG8_SA(0, 1), cA + hstep, voffA);
        if (wr == 1) PG8_BAR;
        PG8_WAIT_V(4); PG8_BAR;
        PG8_STAGE(PG8_SB(1, 0), cB + kstep, voffB); PG8_STAGE(PG8_SA(1, 0), cA + kstep, voffA); PG8_STAGE(PG8_SB(1, 1), cB + hstep + kstep, voffB);
        PG8_WAIT_V(6); PG8_BAR;
    }
    for (;;) {
        const bool has_next = S.next(ui + 1, nxt);
        const char* nA = has_next ? (const char*)g.A + (size_t)nxt.pm * tstep : cA; const char* nB = has_next ? (const char*)g.Bt + (size_t)nxt.pn * tstep : cB;
        for (int t = 0; t < nt; t += 2) {
            const bool last = (t == nt - 2);
            const char* a1 = cA + (size_t)(t + 1) * kstep;
            const char* a2 = last ? nA : cA + (size_t)(t + 2) * kstep; const char* b2 = last ? nB : cB + (size_t)(t + 2) * kstep;
            const char* a3 = a2 + kstep; const char* b3 = b2 + kstep;
            if (last && has_next) S.a_ready(nxt);
            if constexpr (SP2) {
            PG8_LDB(B0, 0, 0); PG8_LDB(B1, 0, 1); PG8_SCHED; PG8_LDA(At, 0, 0); PG8_STAGE(PG8_SA(1, 1), a1 + hstep, voffA);
            PG8_WAIT_V(8); PG8_WAIT_L(0); PG8_BAR; PG8_MMA(0, 0, At, B0); PG8_MMA(0, 1, At, B1); PG8_BAR; PG8_SCHED;
            PG8_LDA(At, 0, 1); PG8_STAGE(PG8_SB(0, 0), b2, voffB); PG8_STAGE(PG8_SB(0, 1), b2 + hstep, voffB); PG8_STAGE(PG8_SA(0, 0), a2, voffA);
            PG8_WAIT_V(8); PG8_WAIT_L(0); PG8_BAR; PG8_MMA(1, 0, At, B0); PG8_MMA(1, 1, At, B1); PG8_BAR; PG8_SCHED;
            PG8_LDB(B0, 1, 0); PG8_LDB(B1, 1, 1); PG8_SCHED; PG8_LDA(At, 1, 0); PG8_STAGE(PG8_SA(0, 1), a2 + hstep, voffA);
            PG8_WAIT_V(8); PG8_WAIT_L(0); PG8_BAR; PG8_MMA(0, 0, At, B0); PG8_MMA(0, 1, At, B1); PG8_BAR; PG8_SCHED;
            PG8_LDA(At, 1, 1); PG8_STAGE(PG8_SB(1, 0), b3, voffB); PG8_STAGE(PG8_SB(1, 1), b3 + hstep, voffB); PG8_STAGE(PG8_SA(1, 0), a3, voffA);
            PG8_WAIT_V(8); PG8_WAIT_L(0); PG8_BAR; PG8_MMA(1, 0, At, B0); PG8_MMA(1, 1, At, B1); PG8_BAR; PG8_SCHED;
            } else {
            PG8_LDB(B0, 0, 0); PG8_SCHED; PG8_LDA(At, 0, 0); PG8_STAGE(PG8_SA(1, 1), a1 + hstep, voffA);
            PG8_WAIT_L(8); PG8_BAR; PG8_WAIT_L(0); PG8_MMA(0, 0, At, B0); PG8_BAR; PG8_SCHED;
            PG8_LDB(B1, 0, 1); PG8_STAGE(PG8_SB(0, 0), b2, voffB);
            PG8_BAR; PG8_WAIT_L(0); PG8_MMA(0, 1, At, B1); PG8_BAR;
            PG8_LDA(At, 0, 1); PG8_STAGE(PG8_SA(0, 0), a2, voffA);
            PG8_BAR; PG8_WAIT_L(0); PG8_MMA(1, 0, At, B0); PG8_BAR; PG8_SCHED;
            PG8_STAGE(PG8_SB(0, 1), b2 + hstep, voffB);
            PG8_WAIT_V(6); PG8_BAR; PG8_MMA(1, 1, At, B1); PG8_BAR;
            PG8_LDB(B0, 1, 0); PG8_SCHED; PG8_LDA(At, 1, 0); PG8_STAGE(PG8_SA(0, 1), a2 + hstep, voffA);
            PG8_WAIT_L(8); PG8_BAR; PG8_WAIT_L(0); PG8_MMA(0, 0, At, B0); PG8_BAR; PG8_SCHED;
            PG8_LDB(B1, 1, 1); PG8_STAGE(PG8_SB(1, 0), b3, voffB);
            PG8_BAR; PG8_WAIT_L(0); PG8_MMA(0, 1, At, B1); PG8_BAR;
            PG8_LDA(At, 1, 1); PG8_STAGE(PG8_SA(1, 0), a3, voffA);
            PG8_BAR; PG8_WAIT_L(0); PG8_MMA(1, 0, At, B0); PG8_BAR; PG8_SCHED;
            PG8_STAGE(PG8_SB(1, 1), b3 + hstep, voffB);
            PG8_WAIT_V(6); PG8_BAR; PG8_MMA(1, 1, At, B1); PG8_BAR;
            }
        }
        if constexpr (ALIGN_EPI) { if (wr == 0) PG8_BAR; }
        if constexpr (!Epi::AFTER_DRAIN) { E(acc, cur, wr, wc, fr, fq); S.done(cur); }
        if (!has_next) break;
#pragma unroll
        for (int a = 0; a < 2; ++a)
#pragma unroll
            for (int b = 0; b < 2; ++b)
#pragma unroll
                for (int m = 0; m < 4; ++m)
#pragma unroll
                    for (int n = 0; n < 2; ++n) acc[a][b][m][n] = (f32x4){0.f, 0.f, 0.f, 0.f};
        cur = nxt; cA = nA; cB = nB; ++ui;
        if constexpr (ALIGN_EPI) { if (wr == 1) PG8_BAR; }
    }
    PG8_WAIT_V(0);
    if constexpr (!ALIGN_EPI) { if (wr == 0) PG8_BAR; }
    PG8_BAR;
    if constexpr (Epi::AFTER_DRAIN) { E.fused(acc, cur, wr, wc, fr, fq, lds, wid, lane); S.done(cur); }
#undef PG8_SA
#undef PG8_SB
#undef PG8_STAGE
#undef PG8_LDA
#undef PG8_LDB
#undef PG8_MMA
#undef PG8_WAIT_V
#undef PG8_WAIT_L
#undef PG8_BAR
#undef PG8_SCHED
}
}
namespace att {
#define ALAS __attribute__((address_space(3)))
using bf16x8 = __attribute__((ext_vector_type(8))) short;
using s16x4 = __attribute__((ext_vector_type(4))) short;
using f32x16 = __attribute__((ext_vector_type(16))) float;
using u32x4 = __attribute__((ext_vector_type(4))) unsigned;
typedef short v4i16_t __attribute__((ext_vector_type(4)));
typedef float f32x2_t __attribute__((ext_vector_type(2))); typedef __bf16 bf16x2_t __attribute__((ext_vector_type(2)));
typedef unsigned short bf16;
typedef ALAS const char* lds_cptr;
constexpr float NEGV = -30000.f;
constexpr float MINIT = -100.f;
constexpr float THR = 8.f;
__device__ __forceinline__ int crow(int r, int hi) { return (r & 3) + 8 * (r >> 2) + 4 * hi; }
__device__ __forceinline__ void glds16(const void* gsrc, unsigned lds_dst) { unsigned keep;
    asm volatile("s_mov_b32 %0, m0\n\ts_mov_b32 m0, %2\n\ts_nop 0\n\tglobal_load_lds_dwordx4 %1, off\n\ts_mov_b32 m0, %0" : "=&s"(keep) : "v"(gsrc), "s"(lds_dst) : "memory"); }
__device__ __forceinline__ unsigned cvtpk(float lo, float hi) { f32x2_t v = {lo, hi}; bf16x2_t b = __builtin_convertvector(v, bf16x2_t); return __builtin_bit_cast(unsigned, b); }
__device__ __forceinline__ float bf2f(short s) { return __uint_as_float(((unsigned)(unsigned short)s) << 16); }
__device__ __forceinline__ s16x4 vtr(lds_cptr p) { return __builtin_bit_cast(s16x4, __builtin_amdgcn_ds_read_tr16_b64_v4i16((ALAS v4i16_t*)p)); }
__device__ __forceinline__ float swap_add(float v) { auto rr = __builtin_amdgcn_permlane32_swap(__float_as_uint(v), __float_as_uint(v), false, false); return __uint_as_float(rr[0]) + __uint_as_float(rr[1]); }
__device__ __forceinline__ float swap_max(float v) { auto rr = __builtin_amdgcn_permlane32_swap(__float_as_uint(v), __float_as_uint(v), false, false); return __builtin_fmaxf(__uint_as_float(rr[0]), __uint_as_float(rr[1])); }
#define ATT_WAIT_BAR(N) asm volatile("s_waitcnt vmcnt(" #N ") lgkmcnt(0)\n\ts_barrier" ::: "memory")
#define ATT_MFMA(a, b, c) __builtin_amdgcn_mfma_f32_32x32x16_bf16((a), (b), (c), 0, 0, 0)

constexpr int SPITCH = 3072;
constexpr int SEQ = 2048;
template <int DV> struct SelfLay { static constexpr int VS = 64 * DV * 2, K0 = 0, V0 = 3 * 8192, WS = V0 + 3 * VS, END = WS + 8 * 256; };

template <int DV, bool MOBA>
__device__ __forceinline__ void self_unit(ALAS unsigned char* lds, const bf16* Qp, const bf16* Kp, const bf16* Vp, bf16* Op, int opitch, int qb, const ALAS float* tab, float tabmax,
                                          const float* kn  , const float* ks  , int b, int kcol  ) {
    typedef SelfLay<DV> L;
    constexpr int NDV = DV / 32, NVP = DV / 64;
    const int tid = threadIdx.x, lane = tid & 63, r32 = lane & 31, hi = lane >> 5; const int wid = __builtin_amdgcn_readfirstlane(tid >> 6);
    const int q0 = qb * 256, qw = q0 + wid * 32, qpos = qw + r32;
    const int NT = (q0 + 256) / 64;
    const unsigned lds0 = (unsigned)(uintptr_t)lds;
    ALAS float* wsf = (ALAS float*)(lds + L::WS) + wid * 64;
    ALAS float* wsfh = wsf + 4 * hi;
    bf16x8 qr[4];
#pragma unroll
    for (int s = 0; s < 4; ++s) qr[s] = *(const bf16x8*)(Qp + (size_t)(qw + r32) * SPITCH + s * 16 + hi * 8);
    unsigned selmask = 0xffu;
    if constexpr (MOBA) {
        if (qb >= 4) {
            ALAS float* km = (ALAS float*)(lds + 16384);
            if (tid < 448 && (tid >> 6) < qb) { const int n = tid >> 6, d = tid & 63; const int pn = kcol >> 8, tc = (kcol & 255) + d;
                const float* p = ks + ((size_t)((8 * b + n) * 12 + pn) * 2) * 256 + tc; km[tid] = p[0] + p[256]; }
            asm volatile("s_waitcnt vmcnt(0) lgkmcnt(0)\n\ts_barrier" ::: "memory");
            float g[7];
#pragma unroll
            for (int n = 0; n < 7; ++n) { float s = 0.f;
                if (n < qb) {
#pragma unroll
                    for (int s4 = 0; s4 < 4; ++s4)
#pragma unroll
                        for (int j = 0; j < 8; ++j) s += bf2f(qr[s4][j]) * km[n * 64 + 16 * s4 + 8 * hi + j];
                }
                s = swap_add(s); g[n] = (n < qb) ? s : -3.0e38f; }
            selmask = 0u;
#pragma unroll
            for (int i = 0; i < 7; ++i) { int cnt = 0;
#pragma unroll
                for (int j = 0; j < 7; ++j) if (j != i) cnt += (g[j] > g[i] || (g[j] == g[i] && j < i)) ? 1 : 0;
                if (i < qb && cnt < 3) selmask |= 1u << i; }
            asm volatile("s_waitcnt lgkmcnt(0)\n\ts_barrier" ::: "memory");
        }
    }
    const bf16* ksrc = Kp + (size_t)lane * SPITCH + wid * 8;
    const unsigned kdst = lds0 + L::K0 + wid * 1024;
#define ATT_DMA_K(t, slot) glds16(ksrc + (size_t)(t) * 64 * SPITCH, (unsigned)__builtin_amdgcn_readfirstlane(kdst + (slot) * 8192))
#define ATT_DMA_V(t, slot) do { _Pragma("unroll") for (int i_ = 0; i_ < NVP; ++i_) { const int p_ = wid + 8 * i_; \
        glds16(Vp + (size_t)((t) * 64 + 16 * (p_ & 3) + (lane >> 2)) * SPITCH + (p_ >> 2) * 32 + (lane & 3) * 8, (unsigned)__builtin_amdgcn_readfirstlane(lds0 + L::V0 + (slot) * L::VS + p_ * 1024)); } } while (0)
    ATT_DMA_K(0, 0); ATT_DMA_V(0, 0); ATT_DMA_K(1, 1); ATT_DMA_V(1, 1);
    float mrow;
    { float q2 = 0.f;
#pragma unroll
      for (int s4 = 0; s4 < 4; ++s4)
#pragma unroll
          for (int j = 0; j < 8; ++j) { const float f = bf2f(qr[s4][j]); q2 += f * f; }
      q2 = swap_add(q2);
      const int pn = kcol >> 8, bj = (kcol >> 7) & 1, wc0 = (kcol & 127) >> 5; float ka = 0.f, kb2 = 0.f;
#pragma unroll
      for (int e = 0; e < 16; ++e) { const float* p = kn + ((size_t)((8 * b + (e >> 1)) * 12 + pn) * 8 + (e & 1) * 4 + wc0) * 2 + bj; ka = __builtin_fmaxf(ka, p[0]); kb2 = __builtin_fmaxf(kb2, p[2]); }
      mrow = sqrtf(q2 * (ka + kb2)) * 1.01f + tabmax + 0.1f; }
    float lsum = 0.f; f32x16 o[NDV];
#pragma unroll
    for (int d = 0; d < NDV; ++d) o[d] = f32x16{};
    f32x16 negm;
#pragma unroll
    for (int r = 0; r < 16; ++r) negm[r] = -mrow;
    const lds_cptr kp0 = (lds_cptr)lds + L::K0 + hi * 1024 + r32 * 16;
    const lds_cptr vp0 = (lds_cptr)lds + L::V0 + ((lane >> 4) & 1) * 32 + (lane & 3) * 8 + (4 * hi + ((lane & 15) >> 2)) * 64;
    int slot = 0, slot2 = 2;
    for (int t = 0; t < NT; ++t) {
        if (t + 1 < NT) { if (NVP == 1) ATT_WAIT_BAR(2); else ATT_WAIT_BAR(3); } else ATT_WAIT_BAR(0);
        if (t + 2 < NT) { ATT_DMA_K(t + 2, slot2); ATT_DMA_V(t + 2, slot2); }
        if (64 * t <= qw + 31) {
            f32x16 ci = negm;
            if constexpr (MOBA) { const int blk = t >> 2; if (blk < qb) { const bool keep = (selmask >> blk) & 1u;
#pragma unroll
                for (int r = 0; r < 16; ++r) ci[r] = keep ? negm[r] : NEGV; } }
            f32x16 p0, p1;
            { const lds_cptr kp = kp0 + slot * 8192;
#pragma unroll
              for (int s = 0; s < 4; ++s) { const bf16x8 k0 = *(const ALAS bf16x8*)(kp + s * 2048), k1 = *(const ALAS bf16x8*)(kp + s * 2048 + 512);
                  if (s == 0) { p0 = ATT_MFMA(k0, qr[0], ci); p1 = ATT_MFMA(k1, qr[0], ci); } else { p0 = ATT_MFMA(k0, qr[s], p0); p1 = ATT_MFMA(k1, qr[s], p1); } } }
            if (64 * t + 191 > qw) {
                const int kb = 64 * t + 4 * hi;
#pragma unroll
                for (int r = 0; r < 16; ++r) { const int d0 = qpos - (kb + (r & 3) + 8 * (r >> 2)), d1 = d0 - 32;
                    const float b0 = tab[d0 < 0 ? 0 : (d0 > 128 ? 128 : d0)], b1 = tab[d1 < 0 ? 0 : (d1 > 128 ? 128 : d1)];
                    p0[r] = d0 < 0 ? NEGV : p0[r] + b0; p1[r] = d1 < 0 ? NEGV : p1[r] + b1; }
            }
            float sacc = 0.f;
#pragma unroll
            for (int r = 0; r < 16; ++r) { p0[r] = __builtin_amdgcn_exp2f(p0[r]); p1[r] = __builtin_amdgcn_exp2f(p1[r]); sacc += p0[r] + p1[r]; }
            lsum += sacc;
            u32x4 pw[4];
#pragma unroll
            for (int i = 0; i < 4; ++i) { pw[0][i] = cvtpk(p0[2 * i], p0[2 * i + 1]); pw[1][i] = cvtpk(p0[8 + 2 * i], p0[8 + 2 * i + 1]); pw[2][i] = cvtpk(p1[2 * i], p1[2 * i + 1]); pw[3][i] = cvtpk(p1[8 + 2 * i], p1[8 + 2 * i + 1]); }
            const lds_cptr vp = vp0 + slot * L::VS;
#pragma unroll
            for (int d = 0; d < NDV; ++d)
#pragma unroll
                for (int s = 0; s < 4; ++s) { const s16x4 lo = vtr(vp + d * 4096 + s * 1024), hh = vtr(vp + d * 4096 + s * 1024 + 512);
                    const bf16x8 vf = (bf16x8){lo[0], lo[1], lo[2], lo[3], hh[0], hh[1], hh[2], hh[3]};
                    o[d] = ATT_MFMA(__builtin_bit_cast(bf16x8, pw[s]), vf, o[d]); if (s == 3) __builtin_amdgcn_sched_barrier(0); }
        }
        slot = (slot == 2) ? 0 : slot + 1; slot2 = (slot2 == 2) ? 0 : slot2 + 1;
    }
    lsum = swap_add(lsum);
    if (hi == 0) wsf[32 + r32] = lsum;
    ATT_WAIT_BAR(0);
    ALAS bf16* stg = (ALAS bf16*)(lds + wid * (32 * DV * 2));
    ALAS bf16* stgh = stg + 4 * hi * DV + r32;
#pragma unroll
    for (int r = 0; r < 16; ++r) { const int oc = (r & 3) + 8 * (r >> 2); const float rl = 1.0f / wsfh[32 + oc];
#pragma unroll
        for (int d = 0; d < NDV; ++d) { const unsigned w = cvtpk(o[d][r] * rl, 0.f); stgh[oc * DV + d * 32] = (bf16)(w & 0xffffu); } }
    asm volatile("s_waitcnt lgkmcnt(0)" ::: "memory");
    constexpr int PPR = DV / 8, RPP = 64 / PPR;
    { const ALAS u32x4* sp = (const ALAS u32x4*)(stg + (lane / PPR) * DV + (lane % PPR) * 8);
      bf16* gp = Op + (size_t)(qw + lane / PPR) * opitch + (lane % PPR) * 8; const size_t gstep = (size_t)RPP * opitch;
#pragma unroll
      for (int i = 0; i < 32 / RPP; ++i) { const u32x4 v = sp[i * (RPP * DV / 8)]; *(u32x4*)(gp + i * gstep) = v; } }
    asm volatile("s_waitcnt vmcnt(0) lgkmcnt(0)\n\ts_barrier" ::: "memory");
#undef ATT_DMA_K
#undef ATT_DMA_V
}

constexpr int XPITCH = 1024, KVPITCH = 2048, X_WS = 132096;
__device__ __forceinline__ void cross_unit(ALAS unsigned char* lds, const bf16* Qp  , const bf16* Kp  , const bf16* Vp  , bf16* Op) {
    const int tid = threadIdx.x, lane = tid & 63, r32 = lane & 31, hi = lane >> 5; const int wid = __builtin_amdgcn_readfirstlane(tid >> 6);
    const unsigned lds0 = (unsigned)(uintptr_t)lds;
    ALAS float* wsf = (ALAS float*)(lds + X_WS) + wid * 64;
#define X_DMA_K(j, slot) do { _Pragma("unroll") for (int i_ = 0; i_ < 4; ++i_) { const int p_ = wid * 4 + i_; \
        glds16(Kp + (size_t)((j) * 64 + lane) * KVPITCH + p_ * 8, (unsigned)__builtin_amdgcn_readfirstlane(lds0 + (slot) * 32768 + p_ * 1024)); } } while (0)
#define X_DMA_V(j, slot) do { _Pragma("unroll") for (int i_ = 0; i_ < 4; ++i_) { const int p_ = wid * 4 + i_; \
        glds16(Vp + (size_t)((j) * 64 + 16 * (p_ & 3) + (lane >> 2)) * KVPITCH + (p_ >> 2) * 32 + (lane & 3) * 8, (unsigned)__builtin_amdgcn_readfirstlane(lds0 + (slot) * 32768 + p_ * 1024)); } } while (0)
#define X_DMA_KH(i, slot) do { _Pragma("unroll") for (int i_ = 0; i_ < 2; ++i_) { const int p_ = wid * 2 + i_; \
        glds16(Kp + (size_t)(((i) & 3) * 64 + lane) * KVPITCH + ((i) >> 2) * 128 + p_ * 8, (unsigned)__builtin_amdgcn_readfirstlane(lds0 + (slot) * 32768 + p_ * 1024)); } } while (0)
    bf16x8 qh[8];
#pragma unroll
    for (int s = 0; s < 8; ++s) qh[s] = *(const bf16x8*)(Qp + (size_t)(wid * 32 + r32) * XPITCH + s * 16 + hi * 8);
    X_DMA_KH(0, 0); X_DMA_KH(1, 1);
    const lds_cptr kp0 = (lds_cptr)lds + hi * 1024 + r32 * 16;
    const lds_cptr vp0 = (lds_cptr)lds + ((lane >> 4) & 1) * 32 + (lane & 3) * 8 + (4 * hi + ((lane & 15) >> 2)) * 64;
    f32x16 p[4][2];
#pragma unroll
    for (int j = 0; j < 4; ++j) { p[j][0] = f32x16{}; p[j][1] = f32x16{}; }
#define X_QK(j, slot) do { lds_cptr kp = kp0 + (slot) * 32768; asm volatile("" : "+v"(kp)); f32x16 a0 = p[j][0], a1 = p[j][1]; \
        _Pragma("unroll") for (int s = 0; s < 8; ++s) { const bf16x8 k0 = *(const ALAS bf16x8*)(kp + s * 2048), k1 = *(const ALAS bf16x8*)(kp + s * 2048 + 512); \
            a0 = ATT_MFMA(k0, qh[s], a0); a1 = ATT_MFMA(k1, qh[s], a1); if ((s & 3) == 3) __builtin_amdgcn_sched_barrier(0); } p[j][0] = a0; p[j][1] = a1; } while (0)
    ATT_WAIT_BAR(2); X_DMA_KH(2, 2); X_QK(0, 0);
    ATT_WAIT_BAR(2); X_DMA_KH(3, 0); X_QK(1, 1);
    ATT_WAIT_BAR(2); X_DMA_KH(4, 1); X_QK(2, 2);
    ATT_WAIT_BAR(2); X_DMA_KH(5, 2); X_QK(3, 0);
#pragma unroll
    for (int s = 0; s < 8; ++s) qh[s] = *(const bf16x8*)(Qp + (size_t)(wid * 32 + r32) * XPITCH + 128 + s * 16 + hi * 8);
    ATT_WAIT_BAR(2); X_DMA_KH(6, 0); X_QK(0, 1);
    ATT_WAIT_BAR(2); X_DMA_KH(7, 1); X_QK(1, 2);
    ATT_WAIT_BAR(2); X_DMA_V(0, 2); X_QK(2, 0);
    ATT_WAIT_BAR(4); X_DMA_V(1, 0); X_QK(3, 1);
    float rm = -3.0e38f;
#pragma unroll
    for (int j = 0; j < 4; ++j)
#pragma unroll
        for (int r = 0; r < 16; ++r) rm = __builtin_fmaxf(rm, __builtin_fmaxf(p[j][0][r], p[j][1][r]));
    rm = swap_max(rm);
    float lsum = 0.f; u32x4 pw[4][4];
#pragma unroll
    for (int j = 0; j < 4; ++j) {
#pragma unroll
        for (int r = 0; r < 16; ++r) { p[j][0][r] = __builtin_amdgcn_exp2f(p[j][0][r] - rm); p[j][1][r] = __builtin_amdgcn_exp2f(p[j][1][r] - rm); lsum += p[j][0][r] + p[j][1][r]; }
#pragma unroll
        for (int i = 0; i < 4; ++i) { pw[j][0][i] = cvtpk(p[j][0][2 * i], p[j][0][2 * i + 1]); pw[j][1][i] = cvtpk(p[j][0][8 + 2 * i], p[j][0][8 + 2 * i + 1]);
            pw[j][2][i] = cvtpk(p[j][1][2 * i], p[j][1][2 * i + 1]); pw[j][3][i] = cvtpk(p[j][1][8 + 2 * i], p[j][1][8 + 2 * i + 1]); }
    }
    lsum = swap_add(lsum);
    f32x16 o[8];
#pragma unroll
    for (int d = 0; d < 8; ++d) o[d] = f32x16{};
#define X_PV(j, slot) do { lds_cptr vp = vp0 + (slot) * 32768; asm volatile("" : "+v"(vp)); \
        _Pragma("unroll") for (int d = 0; d < 8; ++d) _Pragma("unroll") for (int s = 0; s < 4; ++s) { const s16x4 lo = vtr(vp + d * 4096 + s * 1024), hh = vtr(vp + d * 4096 + s * 1024 + 512); \
            const bf16x8 vf = (bf16x8){lo[0], lo[1], lo[2], lo[3], hh[0], hh[1], hh[2], hh[3]}; o[d] = ATT_MFMA(__builtin_bit_cast(bf16x8, pw[j][s]), vf, o[d]); if (s == 3) __builtin_amdgcn_sched_barrier(0); } } while (0)
    ATT_WAIT_BAR(4); X_DMA_V(2, 1); X_PV(0, 2);
    ATT_WAIT_BAR(4); X_DMA_V(3, 2); X_PV(1, 0);
    ATT_WAIT_BAR(4); X_PV(2, 1);
    ATT_WAIT_BAR(0); X_PV(3, 2);
    if (hi == 0) wsf[r32] = lsum;
    ATT_WAIT_BAR(0);
    ALAS bf16* stg = (ALAS bf16*)(lds + wid * 16384);
    ALAS bf16* stgh = stg + 4 * hi * 256 + r32; ALAS float* wsfh = wsf + 4 * hi;
#pragma unroll
    for (int r = 0; r < 16; ++r) { const int oc = (r & 3) + 8 * (r >> 2); const float rl = 1.0f / wsfh[oc];
#pragma unroll
        for (int d = 0; d < 8; ++d) { const unsigned w = cvtpk(o[d][r] * rl, 0.f); stgh[oc * 256 + d * 32] = (bf16)(w & 0xffffu); } }
    asm volatile("s_waitcnt lgkmcnt(0)" ::: "memory");
    { const ALAS u32x4* sp = (const ALAS u32x4*)(stg + (lane >> 5) * 256 + (lane & 31) * 8);
      bf16* gp = Op + (size_t)(wid * 32 + (lane >> 5)) * XPITCH + (lane & 31) * 8;
#pragma unroll
      for (int i = 0; i < 16; ++i) { const u32x4 v = sp[i * 64]; *(u32x4*)(gp + (size_t)i * 2 * XPITCH) = v; } }
    asm volatile("s_waitcnt vmcnt(0) lgkmcnt(0)\n\ts_barrier" ::: "memory");
#undef X_DMA_K
#undef X_DMA_KH
#undef X_DMA_V
#undef X_QK
#undef X_PV
}
}

#define GAS __attribute__((address_space(1)))
#define LAS __attribute__((address_space(3)))
typedef unsigned short bf16;
typedef unsigned v4u __attribute__((ext_vector_type(4)));
typedef float f32x4 __attribute__((ext_vector_type(4)));
typedef short bf16x8 __attribute__((ext_vector_type(8)));
typedef GAS unsigned gu32;
typedef GAS unsigned long long gu64;
#define RLX_AGENT __ATOMIC_RELAXED, __HIP_MEMORY_SCOPE_AGENT
#define LDS_WAIT() asm volatile("s_waitcnt lgkmcnt(0)" ::: "memory")
#define VM_WAIT() asm volatile("s_waitcnt vmcnt(0)" ::: "memory")
__device__ __forceinline__ unsigned long long rt() { return __builtin_amdgcn_s_memrealtime(); }
__device__ __forceinline__ unsigned f2bf(float f) { unsigned u = __builtin_bit_cast(unsigned, f); return (u + 0x7fffu + ((u >> 16) & 1u)) >> 16; }
__device__ __forceinline__ unsigned pk2(float lo, float hi) { return f2bf(lo) | (f2bf(hi) << 16); }
#define XB_TMO      128
#define XB_XCNT(j)  (256  + 64 * (j))
#define XB_XSUB(j)  (1280 + 64 * (j))
#define XB_XGEN(j)  (2304 + 64 * (j))
#define XB_TOP      3328
#define XB_TOPGEN   3392
#define XCD_BAR_WORDS 3456
#define XB_SPIN_CAP (1u << 18)

__device__ __forceinline__ unsigned xb_ld(unsigned* p)              { return __hip_atomic_load(p, __ATOMIC_RELAXED, __HIP_MEMORY_SCOPE_AGENT); }
__device__ __forceinline__ unsigned xb_add(unsigned* p, unsigned v) { return __hip_atomic_fetch_add(p, v, __ATOMIC_RELAXED, __HIP_MEMORY_SCOPE_AGENT); }
__device__ __forceinline__ unsigned xb_xcc_id() { return (unsigned)__builtin_amdgcn_s_getreg((3 << 11) | 20) & 0xFu; }
#define XB_SPIN(cond, bar) do { unsigned _sp = 0; while (cond) { __builtin_amdgcn_s_sleep(1); \
    if ((++_sp & 255u) == 0u) { if (xb_ld(&(bar)[XB_TMO])) break; if (_sp > XB_SPIN_CAP) { atomicAdd(&(bar)[XB_TMO], 1u); break; } } } } while (0)

struct XcdBarrier {
    unsigned* bar; unsigned x;
    volatile LAS unsigned* st;
};

__device__ __forceinline__ XcdBarrier xcd_barrier_post(unsigned* bar, volatile LAS unsigned* st) {
    XcdBarrier b; b.bar = bar; b.x = xb_xcc_id(); b.st = st;
    if (threadIdx.x == 0) (void)xb_add(&bar[XB_XCNT(b.x)], 1u);
    return b;
}
__device__ __forceinline__ void xcd_barrier_complete(unsigned* bar, unsigned x, unsigned& nloc, unsigned& nx) {
    const unsigned G = gridDim.x * gridDim.y * gridDim.z;
    unsigned sum, cnt, mine, sp = 0u;
    for (;;) {
        sum = 0u; cnt = 0u; mine = 0u;
#pragma unroll
        for (unsigned j = 0; j < 16; ++j) { const unsigned c = xb_ld(&bar[XB_XCNT(j)]); sum += c; cnt += (c > 0u) ? 1u : 0u; mine = (j == x) ? c : mine; }
        if (sum == G) break;
        __builtin_amdgcn_s_sleep(1);
        if ((++sp & 255u) == 0u) { if (xb_ld(&bar[XB_TMO])) break; if (sp > XB_SPIN_CAP) { atomicAdd(&bar[XB_TMO], 1u); break; } }
    }
    nloc = mine > 0u ? mine : 1u; nx = cnt > 0u ? cnt : 1u;
}

__device__ __forceinline__ void xcd_barrier(const XcdBarrier& b) {
    asm volatile("s_waitcnt vmcnt(0)" ::: "memory");
    __syncthreads();
    if (threadIdx.x == 0) {
        unsigned* bar = b.bar;
        __builtin_amdgcn_s_waitcnt(0);
        unsigned nloc = b.st[0], nx = b.st[1];
        if (nloc == 0u) { xcd_barrier_complete(bar, b.x, nloc, nx); b.st[0] = nloc; b.st[1] = nx; }
        const unsigned old = xb_add(&bar[XB_XSUB(b.x)], 1u);
        const unsigned gen = old / nloc;
        if (old + 1u == (gen + 1u) * nloc) {
            __builtin_amdgcn_fence(__ATOMIC_RELEASE, "agent");
            asm volatile("s_waitcnt vmcnt(0)" ::: "memory");
            const unsigned og = xb_add(&bar[XB_TOP], 1u);
            const unsigned tg = og / nx;
            if (og + 1u == (tg + 1u) * nx) xb_add(&bar[XB_TOPGEN], 1u);
            else XB_SPIN(xb_ld(&bar[XB_TOPGEN]) == tg, bar);
            __builtin_amdgcn_fence(__ATOMIC_ACQUIRE, "agent");
            xb_add(&bar[XB_XGEN(b.x)], 1u);
            asm volatile("s_waitcnt vmcnt(0)" ::: "memory");
        } else {
            XB_SPIN(xb_ld(&bar[XB_XGEN(b.x)]) == gen, bar);
            __builtin_amdgcn_fence(__ATOMIC_ACQUIRE, "agent");
            asm volatile("s_waitcnt vmcnt(0)" ::: "memory");
        }
    }
    __syncthreads();
}
constexpr int NWAVES = 8;
#ifndef MK_N_LAUNCHES
#define MK_N_LAUNCHES 1
#endif
constexpr int N_PHASES = 11;
constexpr int N_LAUNCHES = MK_N_LAUNCHES;
static_assert(N_LAUNCHES == 1 || N_LAUNCHES == N_PHASES, "MK_N_LAUNCHES is 1 or 11");

constexpr int BATCH = 8, SEQ = 2048, D = 1024, M = BATCH * SEQ, MEMLEN = 256, MM = BATCH * MEMLEN, FF = 2816, NIN = 3072;
constexpr float LOG2E = 1.4426950408889634f;
constexpr float QS_SELF = 0.125f * LOG2E, QS_CROSS = 0.0625f * LOG2E;
constexpr float EPS = 1e-6f;

constexpr size_t MiB = 1u << 20;
constexpr size_t WS_CTL = 0, CTL_ZERO_BYTES = 1 * MiB;
constexpr size_t WS_WIN = 1 * MiB, WS_WOUT = 7 * MiB, WS_WCQ = 9 * MiB, WS_WCKV = 11 * MiB, WS_WCO = 15 * MiB, WS_WGU = 17 * MiB, WS_WD = 28 * MiB;
constexpr size_t WS_BTAB = 33 * MiB + 512 * 1024, WS_SSQ1 = WS_BTAB + 64 * 1024, WS_SSQ2 = WS_SSQ1 + 256 * 1024, WS_KN = WS_SSQ2 + 256 * 1024  , WS_KS = WS_KN + 64 * 1024  ;
constexpr size_t WS_MN = 36 * MiB, WS_CKV = 40 * MiB;
constexpr size_t WS_A = 48 * MiB;
constexpr size_t WS_B = 80 * MiB;
constexpr size_t WS_OA = 176 * MiB, WS_O12 = 192 * MiB, WS_CQ = 176 * MiB;
constexpr size_t WS_X1 = 224 * MiB, WS_END = 256 * MiB;
static_assert(WS_WD + (size_t)1024 * 2816 * 2 <= WS_BTAB && WS_KS + (size_t)64 * 12 * 2 * 256 * 4 <= WS_MN && WS_CKV + (size_t)2048 * 2048 * 2 <= WS_A && WS_A + 32 * MiB <= WS_B && WS_B + 96 * MiB <= WS_OA && WS_OA + 16 * MiB <= WS_O12 && WS_O12 + 32 * MiB <= WS_X1 && WS_X1 + 32 * MiB <= WS_END && WS_END <= 256 * MiB, "d_ws map");
constexpr int CW_BAR = 4096;

constexpr int RING_OFF = 0, RING_BYTES = 131072;
constexpr int TAB_OFF = RING_BYTES;
constexpr int XWS_OFF = RING_BYTES + 1024;
constexpr int LDSCTL_OFF = RING_BYTES + 4096, MISC_OFF = LDSCTL_OFF + 320;
constexpr int LDS_BYTES = 147456;
static_assert(MISC_OFF + 128 <= LDS_BYTES, "LDS map");
static_assert(att::X_WS == XWS_OFF, "cross scratch offset");

__device__ const unsigned char T5_BUCKET[128] = {0, 1, 2, 3, 4, 5, 6, 7, 8, 9, 10, 11, 12, 13, 14, 15, 16, 16, 16, 17, 17, 18, 18, 18, 19, 19, 19, 20, 20, 20, 20, 21, 21, 21, 21, 22, 22, 22, 22, 22, 23, 23, 23, 23, 23, 23, 24, 24, 24, 24, 24, 24, 25, 25, 25, 25, 25, 25, 25, 26, 26, 26, 26, 26, 26, 26, 26, 27, 27, 27, 27, 27, 27, 27, 27, 27, 27, 28, 28, 28, 28, 28, 28, 28, 28, 28, 28, 29, 29, 29, 29, 29, 29, 29, 29, 29, 29, 29, 29, 30, 30, 30, 30, 30, 30, 30, 30, 30, 30, 30, 30, 30, 30, 31, 31, 31, 31, 31, 31, 31, 31, 31, 31, 31, 31, 31, 31, 31};

struct Frame {
    LAS unsigned char* lds;
    volatile LAS unsigned* MISC;
    gu32* ctl;
    int tid, lane, wave;
    int vcu, G;
};
__device__ __forceinline__ float wave_sum(float v) {
#pragma unroll
    for (int o = 1; o < 64; o <<= 1) v += __shfl_xor(v, o);
    return v;
}
__device__ __forceinline__ void p0_transpose_item(const float* W, int K, int N, bf16* WT, int dst_row0, LAS float* scr, int k0, int n0, int lane, int gmode, const float* g1, const float* g2, float cscale) {
#pragma unroll 8
    for (int i = 0; i < 32; ++i) { const int kk = 2 * i + (lane >> 5), k = k0 + kk;
        float gain = cscale; if (gmode == 1) gain *= g1[k]; else if (gmode == 2) gain *= (k < 512) ? g1[k] : 0.8f * g2[(k - 512) & 127];
        scr[kk * 33 + (lane & 31)] = W[(size_t)k * N + n0 + (lane & 31)] * gain; }
    LDS_WAIT(); asm volatile("" ::: "memory");
    const int c = lane & 7;
#pragma unroll
    for (int j = 0; j < 4; ++j) { const int n = (lane >> 3) + 8 * j; const LAS float* s = scr + (8 * c) * 33 + n;
        v4u o; o.x = pk2(s[0 * 33], s[1 * 33]); o.y = pk2(s[2 * 33], s[3 * 33]); o.z = pk2(s[4 * 33], s[5 * 33]); o.w = pk2(s[6 * 33], s[7 * 33]);
        *(GAS v4u*)(WT + (size_t)(dst_row0 + n) * K + k0 + 8 * c) = o; }
    LDS_WAIT(); asm volatile("" ::: "memory");
}
__device__ __forceinline__ void rms_row_to_bf16(int lane, const float* xrow, const float* g, bf16* orow) {
    const GAS f32x4* xr = (const GAS f32x4*)xrow + lane; const GAS f32x4* gr = (const GAS f32x4*)g + lane;
    f32x4 v[4]; float s = 0.f;
#pragma unroll
    for (int j = 0; j < 4; ++j) { v[j] = xr[64 * j]; s += (v[j].x * v[j].x + v[j].y * v[j].y) + (v[j].z * v[j].z + v[j].w * v[j].w); }
    const float rstd = 1.f / sqrtf(wave_sum(s) * (1.f / 1024.f) + EPS);
    GAS unsigned long long* o8 = (GAS unsigned long long*)orow + lane;
#pragma unroll
    for (int j = 0; j < 4; ++j) { const f32x4 gg = gr[64 * j];
        o8[64 * j] = (unsigned long long)pk2(v[j].x * rstd * gg.x, v[j].y * rstd * gg.y) | ((unsigned long long)pk2(v[j].z * rstd * gg.z, v[j].w * rstd * gg.w) << 32); }
}

struct Args { const float* in[20]; float* out; unsigned char* ws; int ph_lo, ph_hi, li, pad; };
enum { I_X = 0, I_MEM, I_MIXG, I_WIN, I_MOBAG, I_LAMBDA, I_SUBLNG, I_WOUT, I_RELB, I_CROSSG, I_MEMG, I_WCQ, I_WCK, I_WCV, I_WCO, I_FFNG, I_WGATE, I_WUP, I_WDOWN, I_FINALG };

__global__ void __launch_bounds__(NWAVES * 64, 2) mk_fwd(Args args) {
    extern __shared__ __attribute__((aligned(16))) unsigned char lds[];
    Frame F;
    F.lds = (LAS unsigned char*)lds;
    F.MISC = (volatile LAS unsigned*)(F.lds + MISC_OFF);
    F.tid = threadIdx.x; F.lane = F.tid & 63; F.wave = __builtin_amdgcn_readfirstlane(F.tid >> 6);
    F.G = gridDim.x; { const int bx = blockIdx.x; F.vcu = (F.G % 8 == 0) ? (bx % 8) * (F.G / 8) + bx / 8 : bx; }
    unsigned char* ws = args.ws;
    F.ctl = (gu32*)(ws + WS_CTL);
    for (int u = F.tid; u < (LDS_BYTES - LDSCTL_OFF) / 4; u += NWAVES * 64) ((LAS unsigned*)(F.lds + LDSCTL_OFF))[u] = 0u;
    __syncthreads();
    XcdBarrier bar; bar.bar = (unsigned*)(F.ctl + CW_BAR); bar.x = 0; bar.st = nullptr;
    if (N_LAUNCHES == 1) bar = xcd_barrier_post((unsigned*)(F.ctl + CW_BAR), F.MISC + 8);
#define GRID_BAR() do { if (N_LAUNCHES == 1) xcd_barrier(bar); } while (0)
    const int lo = args.ph_lo, hi = args.ph_hi;
#ifndef PH_MASK
#define PH_MASK 0x7ff
#endif
#define IN(k) (((PH_MASK >> (k)) & 1) && lo <= (k) && (k) < hi)
#define BOTH(k) (IN(k) && IN((k) + 1))
#ifndef REP_MASK
#define REP_MASK 0
#endif
#define REPN(k) ((((REP_MASK) >> (k)) & 1) ? 2 : 1)
#define PHASE_PTRS size_t z_ = 0; asm volatile("" : "+s"(z_)); unsigned char* w_ = ws + z_; \
        bf16* const WIN = (bf16*)(w_ + WS_WIN); bf16* const WOUT = (bf16*)(w_ + WS_WOUT); bf16* const WCQ = (bf16*)(w_ + WS_WCQ); bf16* const WCKV = (bf16*)(w_ + WS_WCKV); \
        bf16* const WCO = (bf16*)(w_ + WS_WCO); bf16* const WGU = (bf16*)(w_ + WS_WGU); bf16* const WD = (bf16*)(w_ + WS_WD); \
        float* const BTAB = (float*)(w_ + WS_BTAB); float* const KN = (float*)(w_ + WS_KN); float* const KS = (float*)(w_ + WS_KS); float* const SSQ1 = (float*)(w_ + WS_SSQ1); float* const SSQ2 = (float*)(w_ + WS_SSQ2); \
        bf16* const MN = (bf16*)(w_ + WS_MN); bf16* const CKV = (bf16*)(w_ + WS_CKV); \
        bf16* const XN = (bf16*)(w_ + WS_A); bf16* const MIXED = (bf16*)(w_ + WS_A); bf16* const CO = (bf16*)(w_ + WS_A); \
        bf16* const PROJ = (bf16*)(w_ + WS_B); bf16* const HB = (bf16*)(w_ + WS_B); \
        bf16* const OA = (bf16*)(w_ + WS_OA); bf16* const O12 = (bf16*)(w_ + WS_O12); bf16* const CQ = (bf16*)(w_ + WS_CQ); \
        bf16* const X1 = (bf16*)(w_ + WS_X1); \
        (void)KN; (void)KS; (void)WIN; (void)WOUT; (void)WCQ; (void)WCKV; (void)WCO; (void)WGU; (void)WD; (void)BTAB; (void)SSQ1; (void)SSQ2; (void)MN; (void)CKV; (void)XN; (void)MIXED; (void)CO; (void)PROJ; (void)HB; (void)OA; (void)O12; (void)CQ; (void)X1;
    const int gw = F.vcu * NWAVES + F.wave, NGW = F.G * NWAVES;

    if (IN(0)) {
        PHASE_PTRS
{
        LAS float* scr = (LAS float*)(F.lds + RING_OFF + F.wave * 16384);
        constexpr int I0 = 16 * 96, I1 = 512, I6 = 16 * 88, I8 = 44 * 32;
        constexpr int NITEMS = I0 + 5 * I1 + 2 * I6 + I8;
        for (int it = gw; it < NITEMS; it += NGW) {
            int r = it;
            if (r < I0) { const int kb = r / 96, nb = r % 96, n0 = nb * 32; const float cs = (n0 < 512 || (n0 >= 1536 && n0 < 2048)) ? QS_SELF : 1.f;
                p0_transpose_item(args.in[I_WIN], 1024, 3072, WIN, n0, scr, kb * 64, n0, F.lane, 0, nullptr, nullptr, cs); continue; } r -= I0;
            if (r < I1) { const int kb = r / 32, n0 = (r % 32) * 32; p0_transpose_item(args.in[I_WOUT], 1024, 1024, WOUT, n0, scr, kb * 64, n0, F.lane, 2, args.in[I_MOBAG], args.in[I_SUBLNG], 1.f); continue; } r -= I1;
            if (r < I1) { const int kb = r / 32, n0 = (r % 32) * 32; p0_transpose_item(args.in[I_WCQ], 1024, 1024, WCQ, n0, scr, kb * 64, n0, F.lane, 1, args.in[I_CROSSG], nullptr, QS_CROSS); continue; } r -= I1;
            if (r < I1) { const int kb = r / 32, n0 = (r % 32) * 32; p0_transpose_item(args.in[I_WCK], 1024, 1024, WCKV, n0, scr, kb * 64, n0, F.lane, 0, nullptr, nullptr, 1.f); continue; } r -= I1;
            if (r < I1) { const int kb = r / 32, n0 = (r % 32) * 32; p0_transpose_item(args.in[I_WCV], 1024, 1024, WCKV, 1024 + n0, scr, kb * 64, n0, F.lane, 0, nullptr, nullptr, 1.f); continue; } r -= I1;
            if (r < I1) { const int kb = r / 32, n0 = (r % 32) * 32; p0_transpose_item(args.in[I_WCO], 1024, 1024, WCO, n0, scr, kb * 64, n0, F.lane, 0, nullptr, nullptr, 1.f); continue; } r -= I1;
            if (r < I6) { const int kb = r / 88, n0 = (r % 88) * 32; p0_transpose_item(args.in[I_WGATE], 1024, FF, WGU, 256 * (n0 >> 7) + (n0 & 127), scr, kb * 64, n0, F.lane, 1, args.in[I_FFNG], nullptr, 1.f); continue; } r -= I6;
            if (r < I6) { const int kb = r / 88, n0 = (r % 88) * 32; p0_transpose_item(args.in[I_WUP], 1024, FF, WGU, 256 * (n0 >> 7) + 128 + (n0 & 127), scr, kb * 64, n0, F.lane, 1, args.in[I_FFNG], nullptr, 1.f); continue; } r -= I6;
            { const int kb = r / 32, n0 = (r % 32) * 32; p0_transpose_item(args.in[I_WDOWN], FF, 1024, WD, n0, scr, kb * 64, n0, F.lane, 0, nullptr, nullptr, 1.f); }
        }
        for (int m = gw; m < M + MM; m += NGW) {
            if (m < M) rms_row_to_bf16(F.lane, args.in[I_X] + (size_t)m * D, args.in[I_MIXG], XN + (size_t)m * D);
            else rms_row_to_bf16(F.lane, args.in[I_MEM] + (size_t)(m - M) * D, args.in[I_MEMG], MN + (size_t)(m - M) * D);
        }
        { const int gt = F.vcu * NWAVES * 64 + F.tid;
          if (gt < 12 * 132) { const int h = gt / 132, d = gt % 132; const float* T = args.in[I_RELB];
              float v = 0.f;
              if (d < 128) v = (T[T5_BUCKET[d] * 12 + h] - T[31 * 12 + h]) * LOG2E;
              else if (d == 129) { for (int q = 0; q < 32; ++q) v = fmaxf(v, (T[q * 12 + h] - T[31 * 12 + h]) * LOG2E); }
              BTAB[gt] = v; } }
        }
        if (BOTH(0)) GRID_BAR();
    }

    if (IN(1)) {
        PHASE_PTRS
{
        pg8::Gemm g{XN, WIN, M, NIN, D}; pg8::StaticOrder S; S.init(M, NIN, F.G, (int)blockIdx.x);
        pg8::EpiProj E{PROJ, NIN, KN, KS};
        pg8::gemm_phase<pg8::EpiProj, pg8::StaticOrder, true, true>(F.lds + RING_OFF, g, S, E);
        }
        if (BOTH(1)) GRID_BAR();
    }

    if (IN(2)) {
        PHASE_PTRS
{
        LAS float* tab = (LAS float*)(F.lds + TAB_OFF);
        for (int p = F.vcu; p < 256; p += F.G) {
#ifndef SKIP_MOBA
            { const int bh = p >> 2, b = bh >> 3, h = bh & 7, s = p & 3;
              if (F.tid < 132) tab[F.tid] = BTAB[h * 132 + F.tid];
              const float tabmax = BTAB[h * 132 + 129];
              const bf16* base = PROJ + (size_t)b * SEQ * NIN;
#pragma unroll 1
              for (int i = 0; i < 2; ++i) { const int qb = i == 0 ? 7 - s : s;
                  att::self_unit<64, true>(F.lds + RING_OFF, base + h * 64, base + 512 + h * 64, base + 1024 + h * 64, OA + (size_t)b * SEQ * 512 + h * 64, 512, qb, tab, tabmax, KN, KS, b, 512 + h * 64); } }
#endif
#ifndef SKIP_DIFF
            { const int idx = p >> 2, b = idx >> 3, h = (idx >> 1) & 3, mp = idx & 1, s = p & 3;
              if (F.tid < 132) tab[F.tid] = BTAB[(8 + h) * 132 + F.tid];
              const float tabmax = BTAB[(8 + h) * 132 + 129];
              const bf16* base = PROJ + (size_t)b * SEQ * NIN;
#pragma unroll 1
              for (int i = 0; i < 2; ++i) { const int qb = i == 0 ? 7 - s : s;
                  att::self_unit<128, false>(F.lds + RING_OFF, base + 1536 + h * 128 + mp * 64, base + 2048 + h * 128 + mp * 64, base + 2560 + h * 128, O12 + (size_t)b * SEQ * 1024 + h * 256 + mp * 128, 1024, qb, tab, tabmax, KN, KS, b, 2048 + h * 128 + mp * 64); } }
#endif
        }
        }
        if (BOTH(2)) GRID_BAR();
    }

    if (IN(3)) {
        PHASE_PTRS
{
        const float* lp = args.in[I_LAMBDA];
        const float s1 = wave_sum(lp[F.lane] * lp[64 + F.lane]), s2 = wave_sum(lp[128 + F.lane] * lp[192 + F.lane]);
        const float lam = expf(s1) - expf(s2) + 0.2f;
        for (int m = gw; m < M; m += NGW) {
            const int L = F.lane;
            { const bf16x8 v = *(const GAS bf16x8*)(OA + (size_t)m * 512 + L * 8); float f[8]; float ss = 0.f;
#pragma unroll
              for (int j = 0; j < 8; ++j) { f[j] = att::bf2f(v[j]); ss += f[j] * f[j]; }
              const float rstd = 1.f / sqrtf(wave_sum(ss) * (1.f / 512.f) + EPS);
              v4u o; o.x = pk2(f[0] * rstd, f[1] * rstd); o.y = pk2(f[2] * rstd, f[3] * rstd); o.z = pk2(f[4] * rstd, f[5] * rstd); o.w = pk2(f[6] * rstd, f[7] * rstd);
              *(GAS v4u*)(MIXED + (size_t)m * D + L * 8) = o; }
            { const int h = L >> 4, dd = (L & 15) * 8;
              const bf16x8 a = *(const GAS bf16x8*)(O12 + (size_t)m * 1024 + h * 256 + dd), b = *(const GAS bf16x8*)(O12 + (size_t)m * 1024 + h * 256 + 128 + dd); float f[8]; float ss = 0.f;
#pragma unroll
              for (int j = 0; j < 8; ++j) { f[j] = att::bf2f(a[j]) - lam * att::bf2f(b[j]); ss += f[j] * f[j]; }
              ss += __shfl_xor(ss, 1); ss += __shfl_xor(ss, 2); ss += __shfl_xor(ss, 4); ss += __shfl_xor(ss, 8);
              const float rstd = 1.f / sqrtf(ss * (1.f / 128.f) + EPS);
              v4u o; o.x = pk2(f[0] * rstd, f[1] * rstd); o.y = pk2(f[2] * rstd, f[3] * rstd); o.z = pk2(f[4] * rstd, f[5] * rstd); o.w = pk2(f[6] * rstd, f[7] * rstd);
              *(GAS v4u*)(MIXED + (size_t)m * D + 512 + h * 128 + dd) = o; }
        }
        }
        if (BOTH(3)) GRID_BAR();
    }

    if (IN(4)) {
        PHASE_PTRS
{
        pg8::Gemm g{MIXED, WOUT, M, D, D}; pg8::StaticOrder S; S.init(M, D, F.G, (int)blockIdx.x);
        pg8::EpiResid<true, false> E{args.in[I_X], X1, SSQ1, D};
        pg8::gemm_phase<pg8::EpiResid<true, false>, pg8::StaticOrder, false, true>(F.lds + RING_OFF, g, S, E);
        }
        if (BOTH(4)) GRID_BAR();
    }

    if (IN(5)) {
        PHASE_PTRS
{
        { pg8::Gemm g{X1, WCQ, M, D, D}; pg8::StaticOrder S; S.init(M, D, F.G, (int)blockIdx.x);
          pg8::EpiStore E{CQ, D, SSQ1};
          pg8::gemm_phase<pg8::EpiStore, pg8::StaticOrder, true, true>(F.lds + RING_OFF, g, S, E); }
        { pg8::Gemm g{MN, WCKV, MM, 2 * D, D}; pg8::StaticOrder S; S.init(MM, 2 * D, F.G, (int)blockIdx.x);
          pg8::EpiStore E{CKV, 2 * D, nullptr};
          pg8::gemm_phase<pg8::EpiStore, pg8::StaticOrder, true, true>(F.lds + RING_OFF, g, S, E); }
        }
        if (BOTH(5)) GRID_BAR();
    }

    if (IN(6)) {
        PHASE_PTRS
{
        for (int p = F.vcu; p < 256; p += F.G) { const int b = p >> 5, h = (p >> 3) & 3, qb = p & 7;
            att::cross_unit(F.lds + RING_OFF, CQ + (size_t)(b * SEQ + qb * 256) * D + h * 256, CKV + (size_t)(b * MEMLEN) * 2048 + h * 256, CKV + (size_t)(b * MEMLEN) * 2048 + 1024 + h * 256,
                            CO + (size_t)(b * SEQ + qb * 256) * D + h * 256); }
        }
        if (BOTH(6)) GRID_BAR();
    }

    if (IN(7)) {
        PHASE_PTRS
{
        pg8::Gemm g{CO, WCO, M, D, D}; pg8::StaticOrder S; S.init(M, D, F.G, (int)blockIdx.x);
        pg8::EpiResid<false, false> E{X1, X1, SSQ2, D};
        pg8::gemm_phase<pg8::EpiResid<false, false>, pg8::StaticOrder, false, true>(F.lds + RING_OFF, g, S, E);
        }
        if (BOTH(7)) GRID_BAR();
    }

    if (IN(8)) {
        PHASE_PTRS
{
        pg8::Gemm g{X1, WGU, M, 2 * FF, D}; pg8::StaticOrder S; S.init(M, 2 * FF, F.G, (int)blockIdx.x);
        pg8::EpiSwiGLU E{HB, FF, SSQ2};
        pg8::gemm_phase<pg8::EpiSwiGLU, pg8::StaticOrder, true, true>(F.lds + RING_OFF, g, S, E);
        }
        if (BOTH(8)) GRID_BAR();
    }

    if (IN(9)) {
        PHASE_PTRS
{
        pg8::Gemm g{HB, WD, M, D, FF}; pg8::StaticOrder S; S.init(M, D, F.G, (int)blockIdx.x);
        pg8::EpiResid<false, true> E{X1, args.out, nullptr, D};
        pg8::gemm_phase<pg8::EpiResid<false, true>, pg8::StaticOrder, false, true>(F.lds + RING_OFF, g, S, E);
        }
        if (BOTH(9)) GRID_BAR();
    }

    if (IN(10)) {
        PHASE_PTRS
        const GAS f32x4* gr = (const GAS f32x4*)args.in[I_FINALG] + F.lane;
        f32x4 gg[4];
#pragma unroll
        for (int j = 0; j < 4; ++j) gg[j] = gr[64 * j];
        for (int m = gw; m < M; m += NGW) {
            GAS f32x4* xr = (GAS f32x4*)(args.out + (size_t)m * D) + F.lane;
            f32x4 v[4]; float s = 0.f;
#pragma unroll
            for (int j = 0; j < 4; ++j) { v[j] = xr[64 * j]; s += (v[j].x * v[j].x + v[j].y * v[j].y) + (v[j].z * v[j].z + v[j].w * v[j].w); }
            const float rstd = 1.f / sqrtf(wave_sum(s) * (1.f / 1024.f) + EPS);
#pragma unroll
            for (int j = 0; j < 4; ++j) xr[64 * j] = v[j] * rstd * gg[j];
        }
    }
#undef IN
#undef BOTH
#undef GRID_BAR
}

extern "C" void kernel_launch(void* const* d_in, const int* in_sizes, int n_in, void* d_out, int out_size, void* d_ws, size_t ws_size, hipStream_t stream) {
    static int grid = 0;
    if (grid == 0) {
        if (n_in != 20 || in_sizes[0] != M * D || out_size != M * D || ws_size < WS_END) { fprintf(stderr, "kernel_launch: unexpected shapes (n_in %d, in0 %d, out %d, ws %zu); nothing launched\n", n_in, n_in > 0 ? in_sizes[0] : -1, out_size, ws_size); grid = -1; return; }
        int dev = 0, cus = 0, per_cu = 0;
        if (hipGetDevice(&dev) != hipSuccess || hipDeviceGetAttribute(&cus, hipDeviceAttributeMultiprocessorCount, dev) != hipSuccess) { grid = -1; return; }
        if (hipFuncSetAttribute((const void*)mk_fwd, hipFuncAttributeMaxDynamicSharedMemorySize, LDS_BYTES) != hipSuccess) { fprintf(stderr, "kernel_launch: hipFuncSetAttribute failed\n"); grid = -1; return; }
        if (hipOccupancyMaxActiveBlocksPerMultiprocessor(&per_cu, (const void*)mk_fwd, NWAVES * 64, LDS_BYTES) != hipSuccess || per_cu < 1) { fprintf(stderr, "kernel_launch: occupancy query says %d workgroups per CU; nothing launched\n", per_cu); (void)hipGetLastError(); grid = -1; return; }
        (void)hipGetLastError();
        grid = cus;
        if (grid != 256) { fprintf(stderr, "kernel_launch: built for 256 CUs, found %d; nothing launched\n", cus); grid = -1; return; }
    }
    if (grid < 0) return;
    if (hipMemsetAsync((char*)d_ws + WS_CTL, 0, CTL_ZERO_BYTES, stream) != hipSuccess) return;
    Args a{};
    for (int i = 0; i < 20; ++i) a.in[i] = (const float*)d_in[i];
    a.out = (float*)d_out; a.ws = (unsigned char*)d_ws;
    for (int li = 0; li < N_LAUNCHES; ++li) {
        a.ph_lo = (N_LAUNCHES == 1) ? 0 : li; a.ph_hi = (N_LAUNCHES == 1) ? N_PHASES : li + 1; a.li = li; a.pad = 0;
        hipLaunchKernelGGL(mk_fwd, dim3(grid), dim3(NWAVES * 64), LDS_BYTES, stream, a);
    }
}
```
